# Optimizing an MI355X kernel written in HIP

```python
import math, functools
import jax, jax.numpy as jnp
from jax import lax
import numpy as np

D_MODEL = 1024
BATCH = 4
SEQ = 4096
DEPTH = 1
DEC_BATCH = 32
DEC_SEQ = 8
PAST_LEN = 8192
PAGE_SIZE = 128

N_HEADS = 4
HEAD_DIM = 64
KEY_DIM = 2 * HEAD_DIM
VALUE_DIM = 2 * HEAD_DIM
Q_COLS = N_HEADS * KEY_DIM
ATT_WIDTH = N_HEADS * VALUE_DIM
SCALE = HEAD_DIM ** -0.5
Q_BLOCK = 128
SGU_WIDTH = 512
SGU_GROUPS = 4
SGU_GROUP_DIM = SGU_WIDTH // SGU_GROUPS
CHUNK = 128
D_FF = 2816
IN_COLS = 2 * Q_COLS + ATT_WIDTH + 2 * SGU_WIDTH + 2 * D_MODEL
RMS_EPS = 1e-6
LN_EPS = 1e-5

kernel_name = "diffattn_gmlp_macaron_hybrid_step"


def _lambda_init(layer):
    return 0.8 - 0.6 * math.exp(-0.3 * layer)


def _rms(x, g):
    xf = x.astype(jnp.float32)
    y = xf * lax.rsqrt(jnp.mean(xf * xf, axis=-1, keepdims=True) + RMS_EPS)
    return (y * g.astype(jnp.float32)).astype(x.dtype)


def _layernorm(x, g, b):
    xf = x.astype(jnp.float32)
    mu = jnp.mean(xf, axis=-1, keepdims=True)
    xc = xf - mu
    y = xc * lax.rsqrt(jnp.mean(xc * xc, axis=-1, keepdims=True) + LN_EPS)
    return (y * g.astype(jnp.float32) + b.astype(jnp.float32)).astype(x.dtype)


def _swiglu(x, w_in, w_out):
    gate, up = jnp.split(x @ w_in, 2, axis=-1)
    return (jax.nn.silu(gate) * up) @ w_out


def _diff_lambda(lq1, lk1, lq2, lk2, lam_init):
    f = lambda a: a.astype(jnp.float32)
    return jnp.exp(jnp.sum(f(lq1) * f(lk1))) - jnp.exp(jnp.sum(f(lq2) * f(lk2))) + lam_init


def _diff_weights(s, lam):
    p = jax.nn.softmax(s, axis=-1)
    return p[:, 0] - lam * p[:, 1]


def _attend_prompt(q, k, v, lam):
    b, s = q.shape[:2]
    nblk = s // Q_BLOCK
    qb = q.reshape(b, nblk, Q_BLOCK, N_HEADS, 2, HEAD_DIM).swapaxes(0, 1)
    kpos = jnp.arange(s)

    def one_block(args):
        qi, i = args
        sc = jnp.einsum('bqhcd,bkhcd->bchqk', qi, k, preferred_element_type=jnp.float32) * SCALE
        qpos = i * Q_BLOCK + jnp.arange(Q_BLOCK)
        mask = kpos[None, :] <= qpos[:, None]
        w = _diff_weights(jnp.where(mask, sc, -jnp.inf), lam)
        return jnp.einsum('bhqk,bkhe->bqhe', w.astype(v.dtype), v)

    o = lax.map(one_block, (qb, jnp.arange(nblk)))
    return o.swapaxes(0, 1).reshape(b, s, N_HEADS, VALUE_DIM)


def _attend_sample(q, k, v, lam, k_past, v_past):
    t = q.shape[1]
    p_len = k_past.shape[1]
    s_past = jnp.einsum('bqhcd,bkhcd->bchqk', q, k_past, preferred_element_type=jnp.float32) * SCALE
    s_new = jnp.einsum('bqhcd,bkhcd->bchqk', q, k, preferred_element_type=jnp.float32) * SCALE
    causal = jnp.tril(jnp.ones((t, t), dtype=bool))
    s_new = jnp.where(causal, s_new, -jnp.inf)
    w = _diff_weights(jnp.concatenate([s_past, s_new], axis=-1), lam).astype(v.dtype)
    return (jnp.einsum('bhqk,bkhe->bqhe', w[..., :p_len], v_past)
            + jnp.einsum('bhqk,bkhe->bqhe', w[..., p_len:], v))


def _spatial_chunks(v, w_s, b_s):
    b, s = v.shape[:2]
    vc = v.reshape(b, s // CHUNK, CHUNK, SGU_GROUPS, SGU_GROUP_DIM)
    w = w_s * jnp.tril(jnp.ones((CHUNK, CHUNK), dtype=w_s.dtype))
    out = jnp.einsum('gts,bcsge->bctge', w, vc) + b_s.T[None, None, :, :, None]
    return out.reshape(b, s, SGU_WIDTH)


def _spatial_open_chunk(v, w_s, b_s):
    b, t = v.shape[:2]
    vc = v.reshape(b, t, SGU_GROUPS, SGU_GROUP_DIM)
    w = w_s[:, :t, :t] * jnp.tril(jnp.ones((t, t), dtype=w_s.dtype))
    out = jnp.einsum('gts,bsge->btge', w, vc) + b_s[:, :t].T[None, :, :, None]
    return out.reshape(b, t, SGU_WIDTH)


def _layer(x, attend, spatial, lam_init, n1, f1i, f1o, nm, w_in, lq1, lk1, lq2, lk2, subln,
           ln_g, ln_b, w_s, b_s, wpa, wpb, w_out, n2, f2i, f2o):
    b, t, _ = x.shape
    h = x + 0.5 * _swiglu(_rms(x, n1), f1i, f1o)
    nrm = _rms(h, nm)
    cuts = [int(c) for c in np.cumsum([Q_COLS, Q_COLS, ATT_WIDTH, SGU_WIDTH, SGU_WIDTH, D_MODEL])]
    q, k, v, u, vg, ga, gb = jnp.split(nrm @ w_in, cuts, axis=-1)
    q = q.reshape(b, t, N_HEADS, 2, HEAD_DIM)
    k = k.reshape(b, t, N_HEADS, 2, HEAD_DIM)
    v = v.reshape(b, t, N_HEADS, VALUE_DIM)
    lam = _diff_lambda(lq1, lk1, lq2, lk2, lam_init)
    a = attend(q, k, v, lam)
    a = (_rms(a, subln) * (1.0 - lam_init)).reshape(b, t, ATT_WIDTH)
    vs = _layernorm(jax.nn.gelu(vg, approximate=False), ln_g, ln_b)
    sgu = jax.nn.gelu(u, approximate=False) * spatial(vs, w_s, b_s)
    m = jax.nn.sigmoid(ga) * (a @ wpa) + jax.nn.sigmoid(gb) * (sgu @ wpb)
    h = h + m @ w_out
    out = h + 0.5 * _swiglu(_rms(h, n2), f2i, f2o)
    return out, k.reshape(b, t, N_HEADS, KEY_DIM), v, vs


def setup_inputs(seed: int = 0) -> dict:
    key = jax.random.key(seed)
    ks = iter(jax.random.split(key, 40))
    nrm = lambda shape, scale: jax.random.normal(next(ks), shape, jnp.float32) * scale
    gain = lambda shape: 1.0 + nrm(shape, 0.02)
    n_pages = PAST_LEN // PAGE_SIZE
    n_used = DEC_BATCH * n_pages
    n_pool = n_used + n_used // 4
    page_table = jax.random.permutation(next(ks), n_pool)[:n_used].reshape(DEC_BATCH, n_pages).astype(jnp.int32)
    L = DEPTH
    return {
        "x_prompt": nrm((BATCH, SEQ, D_MODEL), 1.0),
        "x_sample": nrm((DEC_BATCH, DEC_SEQ, D_MODEL), 1.0),
        "cache_k": nrm((L, n_pool, PAGE_SIZE, N_HEADS, KEY_DIM), 1.0),
        "cache_v": nrm((L, n_pool, PAGE_SIZE, N_HEADS, VALUE_DIM), 1.0),
        "page_table": page_table,
        "norm_ffn1": gain((L, D_MODEL)),
        "ffn1_w_in": nrm((L, D_MODEL, 2 * D_FF), D_MODEL ** -0.5),
        "ffn1_w_out": nrm((L, D_FF, D_MODEL), D_FF ** -0.5),
        "norm_mix": gain((L, D_MODEL)),
        "w_in": nrm((L, D_MODEL, IN_COLS), D_MODEL ** -0.5),
        "lambda_q1": nrm((L, HEAD_DIM), 0.1),
        "lambda_k1": nrm((L, HEAD_DIM), 0.1),
        "lambda_q2": nrm((L, HEAD_DIM), 0.1),
        "lambda_k2": nrm((L, HEAD_DIM), 0.1),
        "subln": gain((L, VALUE_DIM)),
        "sgu_ln_g": gain((L, SGU_WIDTH)),
        "sgu_ln_b": nrm((L, SGU_WIDTH), 0.02),
        "sgu_w": nrm((L, SGU_GROUPS, CHUNK, CHUNK), CHUNK ** -0.5),
        "sgu_b": gain((L, SGU_GROUPS, CHUNK)),
        "w_proj_attn": nrm((L, ATT_WIDTH, D_MODEL), ATT_WIDTH ** -0.5),
        "w_proj_sgu": nrm((L, SGU_WIDTH, D_MODEL), SGU_WIDTH ** -0.5),
        "w_out": nrm((L, D_MODEL, D_MODEL), D_MODEL ** -0.5),
        "norm_ffn2": gain((L, D_MODEL)),
        "ffn2_w_in": nrm((L, D_MODEL, 2 * D_FF), D_MODEL ** -0.5),
        "ffn2_w_out": nrm((L, D_FF, D_MODEL), D_FF ** -0.5),
        "norm_final": gain((D_MODEL,)),
    }


def reference(x_prompt, x_sample, cache_k, cache_v, page_table, norm_ffn1, ffn1_w_in, ffn1_w_out,
              norm_mix, w_in, lambda_q1, lambda_k1, lambda_q2, lambda_k2, subln, sgu_ln_g, sgu_ln_b,
              sgu_w, sgu_b, w_proj_attn, w_proj_sgu, w_out, norm_ffn2, ffn2_w_in, ffn2_w_out, norm_final):
    db = x_sample.shape[0]
    past = page_table.shape[1] * PAGE_SIZE
    seq = x_prompt.shape[1]
    tail_start = ((seq - 1) // CHUNK) * CHUNK
    hp, hs = x_prompt, x_sample
    kp, vp, sp, kd, vd, sd = [], [], [], [], [], []
    for l in range(DEPTH):
        w = (norm_ffn1[l], ffn1_w_in[l], ffn1_w_out[l], norm_mix[l], w_in[l], lambda_q1[l], lambda_k1[l],
             lambda_q2[l], lambda_k2[l], subln[l], sgu_ln_g[l], sgu_ln_b[l], sgu_w[l], sgu_b[l],
             w_proj_attn[l], w_proj_sgu[l], w_out[l], norm_ffn2[l], ffn2_w_in[l], ffn2_w_out[l])
        lam_init = _lambda_init(l)
        hp, k_new, v_new, vs_new = _layer(hp, _attend_prompt, _spatial_chunks, lam_init, *w)
        kp.append(k_new); vp.append(v_new); sp.append(vs_new[:, tail_start:])
        k_past = cache_k[l][page_table].reshape(db, past, N_HEADS, 2, HEAD_DIM)
        v_past = cache_v[l][page_table].reshape(db, past, N_HEADS, VALUE_DIM)
        attend_s = functools.partial(_attend_sample, k_past=k_past, v_past=v_past)
        hs, k_new, v_new, vs_new = _layer(hs, attend_s, _spatial_open_chunk, lam_init, *w)
        kd.append(k_new); vd.append(v_new); sd.append(vs_new)
    y_prompt = _rms(hp, norm_final)
    y_sample = _rms(hs, norm_final)
    return (y_prompt, y_sample, jnp.stack(kp), jnp.stack(vp), jnp.stack(sp),
            jnp.stack(kd), jnp.stack(vd), jnp.stack(sd))
```

```cpp
#include <hip/hip_runtime.h>
#include <cstdio>
#include <cstdint>
namespace pg8 {
#define PG8_LAS __attribute__((address_space(3)))
typedef unsigned short bf16_t;
typedef short bf16x8 __attribute__((ext_vector_type(8)));
typedef float f32x4 __attribute__((ext_vector_type(4)));
typedef unsigned u32x4 __attribute__((ext_vector_type(4)));
constexpr int BM = 256, BK = 64, HALF = 128, HTB = HALF * BK * 2  , STAGE_BYTES = 8 * HTB, NXCD = 8, WGM = 8;

__host__ __device__ __forceinline__ int lds_byte(int r, int c) { const int st = (r >> 4) * 2 + (c >> 5), rr = r & 15, cc = c & 31, ob = rr * 64 + cc * 2; return st * 1024 + (ob ^ (((ob >> 9) & 1) << 5)); }
__host__ __device__ __forceinline__ void stage_rc(int b, int& R, int& C) { const int st = b / 1024, sb = b % 1024, swz = sb ^ (((sb >> 9) & 1) << 5); R = (st >> 1) * 16 + swz / 64; C = (st & 1) * 32 + (swz % 64) / 2; }
__host__ __device__ __forceinline__ int perm32(int rho) { const int n = rho >> 4, i = rho & 15; return 8 * (i >> 2) + 4 * n + (i & 3); }

struct Unit { int pm, pn; };
struct Gemm { const bf16_t* A; const bf16_t* Bt; int M, N, K; };

struct StaticOrder {
    int nM, nN, nwg, G, c;
    __host__ __device__ void init(int M, int N, int G_, int c_) { nM = M / BM; nN = N / BM; nwg = nM * nN; G = G_; c = c_; }
    __host__ __device__ bool next(int i, Unit& u) const {
        const long L = (long)i * G + c; if (L >= nwg) return false;
        int wgid = (int)L; { const int q = nwg / NXCD, r = nwg % NXCD, xcd = wgid % NXCD, off = wgid / NXCD; wgid = (xcd < r ? xcd * (q + 1) : r * (q + 1) + (xcd - r) * q) + off; }
        const int nig = WGM * nN, gid = wgid / nig, fm = gid * WGM, gsz = (nM - fm) < WGM ? (nM - fm) : WGM;
        u.pm = fm + ((wgid % nig) % gsz); u.pn = (wgid % nig) / gsz; return true;
    }
    __device__ __forceinline__ void a_ready(const Unit&) const {}
    __device__ __forceinline__ void done(const Unit&) const {}
};

__device__ __forceinline__ unsigned cvt_pk_bf16(float lo, float hi) { unsigned r; asm volatile("v_cvt_pk_bf16_f32 %0, %1, %2" : "=v"(r) : "v"(lo), "v"(hi)); return r; }
typedef float f32x2 __attribute__((ext_vector_type(2)));
__device__ __forceinline__ f32x2 gelu_pk(f32x2 v) {
    const f32x2 av = __builtin_elementwise_abs(v), d = av * 0.2316418882f + 1.0f;
    f32x2 t; t.x = __builtin_amdgcn_rcpf(d.x); t.y = __builtin_amdgcn_rcpf(d.y);
    f32x2 q = t * 0.5307027145f + (-0.7265760135f); q = q * t + 0.7107068705f; q = q * t + (-0.142248368f); q = q * t + 0.127414796f; q = q * t;
    const f32x2 s = (v * v) * (-0.72134752044f);
    f32x2 e; e.x = __builtin_amdgcn_exp2f(s.x); e.y = __builtin_amdgcn_exp2f(s.y);
    const f32x2 m = v * (q * e), r = v - m;
    f32x2 o; o.x = v.x < 0.f ? m.x : r.x; o.y = v.y < 0.f ? m.y : r.y; return o;
}

typedef unsigned u32x2 __attribute__((ext_vector_type(2)));
constexpr int MPROMPT = 16384;
__device__ __forceinline__ float sigm(float x) { return __builtin_amdgcn_rcpf(1.0f + __builtin_amdgcn_exp2f(-1.4426950408889634f * x)); }
__device__ __forceinline__ float hsum4(f32x4 v) { return (v[0] + v[1]) + (v[2] + v[3]); }
__device__ __forceinline__ float hsq4(f32x4 v) { return (v[0] * v[0] + v[1] * v[1]) + (v[2] * v[2] + v[3] * v[3]); }
__device__ __forceinline__ void row_rstd(const float* ss, int row0, float (&rs)[2][4]) {
#pragma unroll
    for (int ai = 0; ai < 2; ++ai)
#pragma unroll
        for (int m = 0; m < 4; ++m) { const f32x4* p = (const f32x4*)(ss + (size_t)(row0 + ai * HALF + m * 16) * 16);
            const f32x4 a = p[0], b = p[1], c = p[2], d = p[3]; const float s = (hsum4(a) + hsum4(b)) + (hsum4(c) + hsum4(d));
            rs[ai][m] = 1.0f / sqrtf(s * (1.0f / 1024.0f) + 1e-6f); }
}
__device__ __forceinline__ u32x4 pack8(f32x4 v0, f32x4 v1) { u32x4 w; w.x = cvt_pk_bf16(v0[0], v0[1]); w.y = cvt_pk_bf16(v0[2], v0[3]); w.z = cvt_pk_bf16(v1[0], v1[1]); w.w = cvt_pk_bf16(v1[2], v1[3]); return w; }
__device__ __forceinline__ f32x4 bf4_lo(u32x4 w) { f32x4 r; r[0] = __uint_as_float(w.x << 16); r[1] = __uint_as_float(w.x & 0xffff0000u); r[2] = __uint_as_float(w.y << 16); r[3] = __uint_as_float(w.y & 0xffff0000u); return r; }
__device__ __forceinline__ f32x4 bf4_hi(u32x4 w) { f32x4 r; r[0] = __uint_as_float(w.z << 16); r[1] = __uint_as_float(w.z & 0xffff0000u); r[2] = __uint_as_float(w.w << 16); r[3] = __uint_as_float(w.w & 0xffff0000u); return r; }

struct EpiSwiglu {
    static constexpr bool PERM = true, AFTER_DRAIN = false;
    bf16_t* O; const float* ss;
    __device__ __forceinline__ void operator()(const f32x4 (&acc)[2][2][4][2], const Unit& u, int wr, int wc, int fr, int fq) const {
        const int row0 = u.pm * BM + wr * 64 + fr, col0 = u.pn * 128 + wc * 32 + 8 * fq;
        float rs[2][4]; row_rstd(ss, row0, rs);
#pragma unroll
        for (int ai = 0; ai < 2; ++ai)
#pragma unroll
            for (int m = 0; m < 4; ++m) { const float rr = rs[ai][m]; f32x4 o[2];
#pragma unroll
                for (int n = 0; n < 2; ++n) { const f32x4 g = acc[ai][0][m][n] * rr, up = acc[ai][1][m][n] * rr;
#pragma unroll
                    for (int e = 0; e < 4; ++e) o[n][e] = g[e] * sigm(g[e]) * up[e]; }
                *(u32x4*)(O + (size_t)(row0 + ai * HALF + m * 16) * 2816 + col0) = pack8(o[0], o[1]); }
    }
};
struct EpiRes {
    static constexpr bool PERM = true, AFTER_DRAIN = false;
    const float* base_lo; const float* base_hi; float* out; bf16_t* outb; float* ss; float scale;
    __device__ __forceinline__ void operator()(const f32x4 (&acc)[2][2][4][2], const Unit& u, int wr, int wc, int fr, int fq) const {
        const int row0 = u.pm * BM + wr * 64 + fr, col0 = u.pn * BM + wc * 32 + 8 * fq;
#pragma unroll
        for (int ai = 0; ai < 2; ++ai)
#pragma unroll
            for (int m = 0; m < 4; ++m) { const int r = row0 + ai * HALF + m * 16;
                const float* bp = (u.pm < 64) ? base_lo + (size_t)r * 1024 : base_hi + (size_t)(r - MPROMPT) * 1024; float q = 0.f;
#pragma unroll
                for (int bj = 0; bj < 2; ++bj) { const int c = col0 + bj * HALF;
                    const f32x4 v0 = *(const f32x4*)(bp + c) + acc[ai][bj][m][0] * scale, v1 = *(const f32x4*)(bp + c + 4) + acc[ai][bj][m][1] * scale;
                    *(f32x4*)(out + (size_t)r * 1024 + c) = v0; *(f32x4*)(out + (size_t)r * 1024 + c + 4) = v1;
                    if (outb) *(u32x4*)(outb + (size_t)r * 1024 + c) = pack8(v0, v1);
                    q += hsq4(v0) + hsq4(v1); }
                q += __shfl_xor(q, 16); q += __shfl_xor(q, 32);
                if (fq == 0) ss[(size_t)r * 16 + u.pn * 4 + wc] = q; }
    }
};
struct EpiInProj {
    static constexpr bool PERM = true, AFTER_DRAIN = false;
    const float* ss; bf16_t *QB, *KB, *VB, *UG, *GA, *GB; float* VG; float* VGS; float* out; float qscale;
    __device__ __forceinline__ void operator()(const f32x4 (&acc)[2][2][4][2], const Unit& u, int wr, int wc, int fr, int fq) const {
        const int row0 = u.pm * BM + wr * 64 + fr, cw = wc * 32 + 8 * fq;
        float rs[2][4]; row_rstd(ss, row0, rs);
        const int pn = u.pn;
        if (pn < 2) {
#pragma unroll
            for (int ai = 0; ai < 2; ++ai)
#pragma unroll
                for (int m = 0; m < 4; ++m) { const float rr = rs[ai][m] * qscale; bf16_t* p = QB + (size_t)(row0 + ai * HALF + m * 16) * 512 + pn * 256 + cw;
#pragma unroll
                    for (int bj = 0; bj < 2; ++bj) *(u32x4*)(p + bj * HALF) = pack8(acc[ai][bj][m][0] * rr, acc[ai][bj][m][1] * rr); }
        } else if (pn < 6) {
            const bool isv = pn >= 4; const int ct = (isv ? pn - 4 : pn - 2) * 256 + cw; bf16_t* B = isv ? VB : KB;
            float* ob = out + (u.pm < 64 ? (isv ? 25427968 : 17039360) : (isv ? 34209792 : 34078720));
#pragma unroll
            for (int ai = 0; ai < 2; ++ai)
#pragma unroll
                for (int m = 0; m < 4; ++m) { const int r = row0 + ai * HALF + m * 16; const float rr = rs[ai][m];
                    float* po = ob + (size_t)(u.pm < 64 ? r : r - MPROMPT) * 512 + ct; bf16_t* pb = B + (size_t)r * 512 + ct;
#pragma unroll
                    for (int bj = 0; bj < 2; ++bj) { const f32x4 v0 = acc[ai][bj][m][0] * rr, v1 = acc[ai][bj][m][1] * rr;
                        *(f32x4*)(po + bj * HALF) = v0; *(f32x4*)(po + bj * HALF + 4) = v1; *(u32x4*)(pb + bj * HALF) = pack8(v0, v1); } }
        } else if (pn < 8) {
#pragma unroll
            for (int ai = 0; ai < 2; ++ai)
#pragma unroll
                for (int m = 0; m < 4; ++m) { const float rr = rs[ai][m]; bf16_t* p = UG + (size_t)(row0 + ai * HALF + m * 16) * 512 + (pn - 6) * 256 + cw;
#pragma unroll
                    for (int bj = 0; bj < 2; ++bj) { const f32x4 v0 = acc[ai][bj][m][0] * rr, v1 = acc[ai][bj][m][1] * rr;
                        const f32x2 a = gelu_pk((f32x2){v0[0], v0[1]}), b = gelu_pk((f32x2){v0[2], v0[3]}), c = gelu_pk((f32x2){v1[0], v1[1]}), d = gelu_pk((f32x2){v1[2], v1[3]});
                        *(u32x4*)(p + bj * HALF) = pack8((f32x4){a.x, a.y, b.x, b.y}, (f32x4){c.x, c.y, d.x, d.y}); } }
        } else if (pn < 10) {
#pragma unroll
            for (int ai = 0; ai < 2; ++ai)
#pragma unroll
                for (int m = 0; m < 4; ++m) { const int r = row0 + ai * HALF + m * 16; const float rr = rs[ai][m]; float* p = VG + (size_t)r * 512 + (pn - 8) * 256 + cw; float s1 = 0.f, s2 = 0.f;
#pragma unroll
                    for (int bj = 0; bj < 2; ++bj) { const f32x4 v0 = acc[ai][bj][m][0] * rr, v1 = acc[ai][bj][m][1] * rr;
                        const f32x2 a = gelu_pk((f32x2){v0[0], v0[1]}), b = gelu_pk((f32x2){v0[2], v0[3]}), c = gelu_pk((f32x2){v1[0], v1[1]}), d = gelu_pk((f32x2){v1[2], v1[3]});
                        const f32x4 g0 = (f32x4){a.x, a.y, b.x, b.y}, g1 = (f32x4){c.x, c.y, d.x, d.y};
                        *(f32x4*)(p + bj * HALF) = g0; *(f32x4*)(p + bj * HALF + 4) = g1; s1 += hsum4(g0) + hsum4(g1); s2 += hsq4(g0) + hsq4(g1); }
                    s1 += __shfl_xor(s1, 16); s1 += __shfl_xor(s1, 32); s2 += __shfl_xor(s2, 16); s2 += __shfl_xor(s2, 32);
                    if (fq == 0) { float* q = VGS + (size_t)r * 16 + ((pn - 8) * 4 + wc) * 2; q[0] = s1; q[1] = s2; } }
        } else {
            const bool isb = pn >= 14; bf16_t* B = isb ? GB : GA; const int ct = (isb ? pn - 14 : pn - 10) * 256 + cw;
#pragma unroll
            for (int ai = 0; ai < 2; ++ai)
#pragma unroll
                for (int m = 0; m < 4; ++m) { const float rr = rs[ai][m]; bf16_t* p = B + (size_t)(row0 + ai * HALF + m * 16) * 1024 + ct;
#pragma unroll
                    for (int bj = 0; bj < 2; ++bj) { f32x4 v0 = acc[ai][bj][m][0] * rr, v1 = acc[ai][bj][m][1] * rr;
#pragma unroll
                        for (int e = 0; e < 4; ++e) { v0[e] = sigm(v0[e]); v1[e] = sigm(v1[e]); }
                        *(u32x4*)(p + bj * HALF) = pack8(v0, v1); } }
        }
    }
};
struct EpiGate1 {
    static constexpr bool PERM = true, AFTER_DRAIN = false;
    const bf16_t* G; float* T;
    __device__ __forceinline__ void operator()(const f32x4 (&acc)[2][2][4][2], const Unit& u, int wr, int wc, int fr, int fq) const {
        const int row0 = u.pm * BM + wr * 64 + fr, col0 = u.pn * BM + wc * 32 + 8 * fq;
#pragma unroll
        for (int ai = 0; ai < 2; ++ai)
#pragma unroll
            for (int m = 0; m < 4; ++m) { const size_t off = (size_t)(row0 + ai * HALF + m * 16) * 1024 + col0;
#pragma unroll
                for (int bj = 0; bj < 2; ++bj) { const u32x4 gw = *(const u32x4*)(G + off + bj * HALF);
                    *(f32x4*)(T + off + bj * HALF) = bf4_lo(gw) * acc[ai][bj][m][0]; *(f32x4*)(T + off + bj * HALF + 4) = bf4_hi(gw) * acc[ai][bj][m][1]; } }
    }
};
struct EpiGate2 {
    static constexpr bool PERM = true, AFTER_DRAIN = false;
    const bf16_t* G; const float* T; bf16_t* O;
    __device__ __forceinline__ void operator()(const f32x4 (&acc)[2][2][4][2], const Unit& u, int wr, int wc, int fr, int fq) const {
        const int row0 = u.pm * BM + wr * 64 + fr, col0 = u.pn * BM + wc * 32 + 8 * fq;
#pragma unroll
        for (int ai = 0; ai < 2; ++ai)
#pragma unroll
            for (int m = 0; m < 4; ++m) { const size_t off = (size_t)(row0 + ai * HALF + m * 16) * 1024 + col0;
#pragma unroll
                for (int bj = 0; bj < 2; ++bj) { const u32x4 gw = *(const u32x4*)(G + off + bj * HALF);
                    const f32x4 v0 = *(const f32x4*)(T + off + bj * HALF) + bf4_lo(gw) * acc[ai][bj][m][0], v1 = *(const f32x4*)(T + off + bj * HALF + 4) + bf4_hi(gw) * acc[ai][bj][m][1];
                    *(u32x4*)(O + off + bj * HALF) = pack8(v0, v1); } }
    }
};

template <class Epi, class Sched, bool ALIGN_EPI = false, bool SP2 = false>
__device__ __forceinline__ void gemm_phase(PG8_LAS unsigned char* lds, const Gemm g, const Sched& S, const Epi& E) {
    const int tid = threadIdx.x, wid = __builtin_amdgcn_readfirstlane(tid >> 6), lane = tid & 63, wr = wid >> 2, wc = wid & 3, fr = lane & 15, fq = lane >> 4;
    const int K = g.K, nt = K / BK;
    unsigned voffA[2], voffB[2];
#pragma unroll
    for (int i = 0; i < 2; ++i) { int R, C; stage_rc(tid * 16 + i * 8192, R, C); const int Rb = Epi::PERM ? ((R & ~31) + perm32(R & 31)) : R;
        voffA[i] = (unsigned)(R * K + C) * 2u; voffB[i] = (unsigned)(Rb * K + C) * 2u; }
    const size_t kstep = (size_t)(BK * 2);
    const size_t hstep = (size_t)HALF * K * 2;
    const size_t tstep = 2 * hstep;
    const unsigned ldsw = (unsigned)wid * 1024u;
    const int aoff = lds_byte(wr * 64 + fr, fq * 8), boff = lds_byte(wc * 32 + fr, fq * 8);
#define PG8_SA(b, h) (((b) * 2 + (h)) * HTB)
#define PG8_SB(b, h) ((4 + (b) * 2 + (h)) * HTB)
#define PG8_STAGE(bufoff, gbase, voff) do { _Pragma("unroll") for (int _i = 0; _i < 2; ++_i) \
        __builtin_amdgcn_global_load_lds((const unsigned*)((const char*)(gbase) + (voff)[_i]), (PG8_LAS unsigned*)(lds + (bufoff) + ldsw + _i * 8192), 16, 0, 0); } while (0)
#define PG8_LDA(dst, b, h) do { _Pragma("unroll") for (int m = 0; m < 4; ++m) _Pragma("unroll") for (int k = 0; k < 2; ++k) dst[m][k] = *(const PG8_LAS bf16x8*)(lds + PG8_SA(b, h) + aoff + m * 2048 + k * 1024); } while (0)
#define PG8_LDB(dst, b, h) do { _Pragma("unroll") for (int n = 0; n < 2; ++n) _Pragma("unroll") for (int k = 0; k < 2; ++k) dst[n][k] = *(const PG8_LAS bf16x8*)(lds + PG8_SB(b, h) + boff + n * 2048 + k * 1024); } while (0)
#define PG8_MMA(ai, bj, At, Bt) do { __builtin_amdgcn_s_setprio(1); _Pragma("unroll") for (int m = 0; m < 4; ++m) _Pragma("unroll") for (int n = 0; n < 2; ++n) _Pragma("unroll") for (int k = 0; k < 2; ++k) \
        acc[ai][bj][m][n] = __builtin_amdgcn_mfma_f32_16x16x32_bf16(Bt[n][k], At[m][k], acc[ai][bj][m][n], 0, 0, 0); __builtin_amdgcn_s_setprio(0); } while (0)
#define PG8_WAIT_V(n) asm volatile("s_waitcnt vmcnt(" #n ")" ::: "memory")
#define PG8_WAIT_L(n) asm volatile("s_waitcnt lgkmcnt(" #n ")" ::: "memory")
#define PG8_BAR __builtin_amdgcn_s_barrier()
#define PG8_SCHED __builtin_amdgcn_sched_barrier(0)
    Unit cur, nxt; int ui = 0;
    if (!S.next(0, cur)) return;
    f32x4 acc[2][2][4][2];
#pragma unroll
    for (int a = 0; a < 2; ++a)
#pragma unroll
        for (int b = 0; b < 2; ++b)
#pragma unroll
            for (int m = 0; m < 4; ++m)
#pragma unroll
                for (int n = 0; n < 2; ++n) acc[a][b][m][n] = (f32x4){0.f, 0.f, 0.f, 0.f};
    bf16x8 At[4][2], B0[2][2], B1[2][2];
    const char* cA = (const char*)g.A + (size_t)cur.pm * tstep; const char* cB = (const char*)g.Bt + (size_t)cur.pn * tstep;
    S.a_ready(cur);
    if constexpr (SP2) {
        PG8_STAGE(PG8_SB(0, 0), cB, voffB); PG8_STAGE(PG8_SB(0, 1), cB + hstep, voffB); PG8_STAGE(PG8_SA(0, 0), cA, voffA); PG8_STAGE(PG8_SA(0, 1), cA + hstep, voffA);
        if (wr == 1) PG8_BAR;
        PG8_WAIT_V(2); PG8_BAR;
        PG8_STAGE(PG8_SB(1, 0), cB + kstep, voffB); PG8_STAGE(PG8_SA(1, 0), cA + kstep, voffA); PG8_STAGE(PG8_SB(1, 1), cB + hstep + kstep, voffB);
        PG8_WAIT_V(6); PG8_BAR;
    } else {
        PG8_STAGE(PG8_SB(0, 0), cB, voffB); PG8_STAGE(PG8_SA(0, 0), cA, voffA); PG8_STAGE(PG8_SB(0, 1), cB + hstep, voffB); PG8_STAGE(PG8_SA(0, 1), cA + hstep, voffA);
        if (wr == 1) PG8_BAR;
        PG8_WAIT_V(4); PG8_BAR;
        PG8_STAGE(PG8_SB(1, 0), cB + kstep, voffB); PG8_STAGE(PG8_SA(1, 0), cA + kstep, voffA); PG8_STAGE(PG8_SB(1, 1), cB + hstep + kstep, voffB);
        PG8_WAIT_V(6); PG8_BAR;
    }
    for (;;) {
        const bool has_next = S.next(ui + 1, nxt);
        const char* nA = has_next ? (const char*)g.A + (size_t)nxt.pm * tstep : cA; const char* nB = has_next ? (const char*)g.Bt + (size_t)nxt.pn * tstep : cB;
        for (int t = 0; t < nt; t += 2) {
            const bool last = (t == nt - 2);
            const char* a1 = cA + (size_t)(t + 1) * kstep;
            const char* a2 = last ? nA : cA + (size_t)(t + 2) * kstep; const char* b2 = last ? nB : cB + (size_t)(t + 2) * kstep;
            const char* a3 = a2 + kstep; const char* b3 = b2 + kstep;
            if (last && has_next) S.a_ready(nxt);
            if constexpr (SP2) {
            PG8_LDB(B0, 0, 0); PG8_LDB(B1, 0, 1); PG8_SCHED; PG8_LDA(At, 0, 0); PG8_STAGE(PG8_SA(1, 1), a1 + hstep, voffA);
            PG8_WAIT_V(8); PG8_WAIT_L(0); PG8_BAR; PG8_MMA(0, 0, At, B0); PG8_MMA(0, 1, At, B1); PG8_BAR; PG8_SCHED;
            PG8_LDA(At, 0, 1); PG8_STAGE(PG8_SB(0, 0), b2, voffB); PG8_STAGE(PG8_SB(0, 1), b2 + hstep, voffB); PG8_STAGE(PG8_SA(0, 0), a2, voffA);
            PG8_WAIT_V(8); PG8_WAIT_L(0); PG8_BAR; PG8_MMA(1, 0, At, B0); PG8_MMA(1, 1, At, B1); PG8_BAR; PG8_SCHED;
            PG8_LDB(B0, 1, 0); PG8_LDB(B1, 1, 1); PG8_SCHED; PG8_LDA(At, 1, 0); PG8_STAGE(PG8_SA(0, 1), a2 + hstep, voffA);
            PG8_WAIT_V(8); PG8_WAIT_L(0); PG8_BAR; PG8_MMA(0, 0, At, B0); PG8_MMA(0, 1, At, B1); PG8_BAR; PG8_SCHED;
            PG8_LDA(At, 1, 1); PG8_STAGE(PG8_SB(1, 0), b3, voffB); PG8_STAGE(PG8_SB(1, 1), b3 + hstep, voffB); PG8_STAGE(PG8_SA(1, 0), a3, voffA);
            PG8_WAIT_V(8); PG8_WAIT_L(0); PG8_BAR; PG8_MMA(1, 0, At, B0); PG8_MMA(1, 1, At, B1); PG8_BAR; PG8_SCHED;
            } else {
            PG8_LDB(B0, 0, 0); PG8_SCHED; PG8_LDA(At, 0, 0); PG8_STAGE(PG8_SA(1, 1), a1 + hstep, voffA);
            PG8_WAIT_L(8); PG8_BAR; PG8_WAIT_L(0); PG8_MMA(0, 0, At, B0); PG8_BAR; PG8_SCHED;
            PG8_LDB(B1, 0, 1); PG8_STAGE(PG8_SB(0, 0), b2, voffB);
            PG8_BAR; PG8_WAIT_L(0); PG8_MMA(0, 1, At, B1); PG8_BAR;
            PG8_LDA(At, 0, 1); PG8_STAGE(PG8_SA(0, 0), a2, voffA);
            PG8_BAR; PG8_WAIT_L(0); PG8_MMA(1, 0, At, B0); PG8_BAR; PG8_SCHED;
            PG8_STAGE(PG8_SB(0, 1), b2 + hstep, voffB);
            PG8_WAIT_V(6); PG8_BAR; PG8_MMA(1, 1, At, B1); PG8_BAR;
            PG8_LDB(B0, 1, 0); PG8_SCHED; PG8_LDA(At, 1, 0); PG8_STAGE(PG8_SA(0, 1), a2 + hstep, voffA);
            PG8_WAIT_L(8); PG8_BAR; PG8_WAIT_L(0); PG8_MMA(0, 0, At, B0); PG8_BAR; PG8_SCHED;
            PG8_LDB(B1, 1, 1); PG8_STAGE(PG8_SB(1, 0), b3, voffB);
            PG8_BAR; PG8_WAIT_L(0); PG8_MMA(0, 1, At, B1); PG8_BAR;
            PG8_LDA(At, 1, 1); PG8_STAGE(PG8_SA(1, 0), a3, voffA);
            PG8_BAR; PG8_WAIT_L(0); PG8_MMA(1, 0, At, B0); PG8_BAR; PG8_SCHED;
            PG8_STAGE(PG8_SB(1, 1), b3 + hstep, voffB);
            PG8_WAIT_V(6); PG8_BAR; PG8_MMA(1, 1, At, B1); PG8_BAR;
            }
        }
        if constexpr (ALIGN_EPI) { if (wr == 0) PG8_BAR; }
        if constexpr (!Epi::AFTER_DRAIN) { E(acc, cur, wr, wc, fr, fq); S.done(cur); }
        if (!has_next) break;
#pragma unroll
        for (int a = 0; a < 2; ++a)
#pragma unroll
            for (int b = 0; b < 2; ++b)
#pragma unroll
                for (int m = 0; m < 4; ++m)
#pragma unroll
                    for (int n = 0; n < 2; ++n) acc[a][b][m][n] = (f32x4){0.f, 0.f, 0.f, 0.f};
        cur = nxt; cA = nA; cB = nB; ++ui;
        if constexpr (ALIGN_EPI) { if (wr == 1) PG8_BAR; }
    }
    PG8_WAIT_V(0);
    if constexpr (!ALIGN_EPI) { if (wr == 0) PG8_BAR; }
    PG8_BAR;
    if constexpr (Epi::AFTER_DRAIN) { E.fused(acc, cur, wr, wc, fr, fq, lds, wid, lane); S.done(cur); }
#undef PG8_SA
#undef PG8_SB
#undef PG8_STAGE
#undef PG8_LDA
#undef PG8_LDB
#undef PG8_MMA
#undef PG8_WAIT_V
#undef PG8_WAIT_L
#undef PG8_BAR
#undef PG8_SCHED
}
}
#include <hip/hip_bf16.h>
#include <cmath>
namespace attn_body {
using bf16=__hip_bfloat16;
using bf16x8=__attribute__((ext_vector_type(8)))short;
using s16x4=__attribute__((ext_vector_type(4)))short;
using f32x16=__attribute__((ext_vector_type(16)))float;
using u32x4=__attribute__((ext_vector_type(4)))unsigned;
constexpr int SEQ=4096,D=64,KP=512,OP=1024;
constexpr int NW=8,QBLK=32,QB=QBLK*NW,KVBLK=64,NQB=SEQ/QB;
__device__ __forceinline__ int crow(int r,int hi){return (r&3)+8*(r>>2)+4*hi;}
#define SBAR() __builtin_amdgcn_sched_barrier(0)
__device__ __forceinline__ void cmask(f32x16&p0,f32x16&p1,int jb,int qrel,int hi){
  const float NEG=-INFINITY; int kb=64*jb+4*hi;
  #pragma unroll
  for(int r=0;r<16;++r){int kv=kb+(r&3)+8*(r>>2); if(kv>qrel)p0[r]=NEG; if(kv+32>qrel)p1[r]=NEG;}
}

constexpr int NSLOT=3, SLOTB=8192;
constexpr int LDS_K=0, LDS_V=NSLOT*SLOTB, LDS_WS=2*NSLOT*SLOTB, LDS_OST=LDS_WS+NW*64*4, LDS_BYTES=LDS_OST+NW*4096;
constexpr float C2=0.125f*1.4426950408889634f;
__device__ __forceinline__ void glds16(const void*gsrc,unsigned lds_dst){unsigned keep;
  asm volatile("s_mov_b32 %0, m0\n\ts_mov_b32 m0, %2\n\ts_nop 0\n\tglobal_load_lds_dwordx4 %1, off\n\ts_mov_b32 m0, %0":"=&s"(keep):"v"(gsrc),"s"(lds_dst):"memory");}
__device__ __forceinline__ float max3f(float a,float b,float c){float r;asm("v_max3_f32 %0, %1, %2, %3":"=v"(r):"v"(a),"v"(b),"v"(c));return r;}
__device__ __forceinline__ float max2f(float a,float b){float r;asm("v_max_f32_e32 %0, %1, %2":"=v"(r):"v"(a),"v"(b));return r;}
__device__ __forceinline__ float fadd_s(float a,float b){float r;asm("v_add_f32_e32 %0, %1, %2":"=v"(r):"v"(a),"v"(b));return r;}
__device__ __forceinline__ float fsub_s(float a,float b){float r;asm("v_sub_f32_e32 %0, %1, %2":"=v"(r):"v"(a),"v"(b));return r;}
typedef float f32x2_t __attribute__((ext_vector_type(2))); typedef __bf16 bf16x2_t __attribute__((ext_vector_type(2)));
__device__ __forceinline__ unsigned cvtpk_s(float lo,float hi){f32x2_t v={lo,hi};bf16x2_t b=__builtin_convertvector(v,bf16x2_t);return __builtin_bit_cast(unsigned,b);}
#define WAIT_BAR(N) asm volatile("s_waitcnt vmcnt(" #N ") lgkmcnt(0)\n\ts_barrier":::"memory")

__device__ __forceinline__ void qkt(f32x16&p0,f32x16&p1,const char*Kslot,const bf16x8*qr,const f32x16&negm,int r32,int hi){
  const char*kb=Kslot+hi*1024+r32*16;
  #pragma unroll
  for(int d0=0;d0<4;++d0){
    const bf16x8 b0=*reinterpret_cast<const bf16x8*>(kb+d0*2048);
    const bf16x8 b1=*reinterpret_cast<const bf16x8*>(kb+d0*2048+512);
    if(d0==0){p0=__builtin_amdgcn_mfma_f32_32x32x16_bf16(b0,qr[0],negm,0,0,0);p1=__builtin_amdgcn_mfma_f32_32x32x16_bf16(b1,qr[0],negm,0,0,0);}
    else{p0=__builtin_amdgcn_mfma_f32_32x32x16_bf16(b0,qr[d0],p0,0,0,0);p1=__builtin_amdgcn_mfma_f32_32x32x16_bf16(b1,qr[d0],p1,0,0,0);}}
}
typedef __attribute__((address_space(3))) const char* lds_cptr;
typedef short v4i16_t __attribute__((ext_vector_type(4)));
__device__ __forceinline__ void kload8(bf16x8*kf,lds_cptr kp){
  kf[0]=*(const __attribute__((address_space(3))) bf16x8*)(kp);      kf[1]=*(const __attribute__((address_space(3))) bf16x8*)(kp+512);
  kf[2]=*(const __attribute__((address_space(3))) bf16x8*)(kp+2048); kf[3]=*(const __attribute__((address_space(3))) bf16x8*)(kp+2560);
  kf[4]=*(const __attribute__((address_space(3))) bf16x8*)(kp+4096); kf[5]=*(const __attribute__((address_space(3))) bf16x8*)(kp+4608);
  kf[6]=*(const __attribute__((address_space(3))) bf16x8*)(kp+6144); kf[7]=*(const __attribute__((address_space(3))) bf16x8*)(kp+6656);
}
__device__ __forceinline__ void kload2(bf16x8*kf,lds_cptr kp,int j){ kf[2*j]=*(const __attribute__((address_space(3))) bf16x8*)(kp+j*2048); kf[2*j+1]=*(const __attribute__((address_space(3))) bf16x8*)(kp+j*2048+512); }
__device__ __forceinline__ s16x4 vtr(lds_cptr p){ return __builtin_bit_cast(s16x4,__builtin_amdgcn_ds_read_tr16_b64_v4i16((__attribute__((address_space(3))) v4i16_t*)p)); }
__device__ __forceinline__ float rowmax(const f32x16&p0,const f32x16&p1){
  float a=max3f(p0[0],p0[1],p1[0]),b=max3f(p0[2],p0[3],p1[1]);a=max3f(a,p1[2],p1[3]);
  #pragma unroll
  for(int r=4;r<16;r+=4){a=max3f(a,p0[r],p0[r+1]);b=max3f(b,p0[r+2],p0[r+3]);a=max3f(a,p1[r],p1[r+1]);b=max3f(b,p1[r+2],p1[r+3]);}
  const float m=max2f(a,b);
  auto rr=__builtin_amdgcn_permlane32_swap(__float_as_uint(m),__float_as_uint(m),false,false);
  return max2f(__uint_as_float(rr[0]),__uint_as_float(rr[1]));
}
__device__ __forceinline__ void pv(f32x16*o,int vb,bf16x8 pa0,bf16x8 pa1,bf16x8 pa2,bf16x8 pa3){
  #pragma unroll
  for(int d0=0;d0<2;++d0){s16x4 lo[4],hi[4];
    #pragma unroll
    for(int ks=0;ks<4;++ks){
      asm volatile("ds_read_b64_tr_b16 %0,%1 offset:%c2":"=&v"(lo[ks]):"v"(vb),"i"(d0*4096+ks*1024):"memory");
      asm volatile("ds_read_b64_tr_b16 %0,%1 offset:%c2":"=&v"(hi[ks]):"v"(vb),"i"(d0*4096+ks*1024+512):"memory");}
    asm volatile("s_waitcnt lgkmcnt(0)":::"memory");SBAR();
    #define PK(k) (bf16x8){lo[k][0],lo[k][1],lo[k][2],lo[k][3],hi[k][0],hi[k][1],hi[k][2],hi[k][3]}
    o[d0]=__builtin_amdgcn_mfma_f32_32x32x16_bf16(pa0,PK(0),o[d0],0,0,0);
    o[d0]=__builtin_amdgcn_mfma_f32_32x32x16_bf16(pa1,PK(1),o[d0],0,0,0);
    o[d0]=__builtin_amdgcn_mfma_f32_32x32x16_bf16(pa2,PK(2),o[d0],0,0,0);
    o[d0]=__builtin_amdgcn_mfma_f32_32x32x16_bf16(pa3,PK(3),o[d0],0,0,0);
    #undef PK
  }
}

#ifndef ATTN_STORE16
#define ATTN_STORE16(p,v) (*(u32x4*)(p)=(v))
#endif
template<int THRL> __device__ __forceinline__ void attn_unit(int b,int qcol,int kcol,int vcol,int ocol,int qb,const bf16*Q,const bf16*__restrict__ K,const bf16*__restrict__ V,bf16*O,char*shm){
  const int tid=threadIdx.x,lane=tid&63,r32=lane&31,hi=lane>>5; const int wid=__builtin_amdgcn_readfirstlane(tid>>6);
  const long rowbase=(long)b*SEQ; const int q0=qb*QB;
  const bf16*Qw=Q+(rowbase+q0+wid*QBLK)*KP+qcol;
  const bf16*Kh=K+rowbase*KP+kcol,*Vh=V+rowbase*KP+vcol;
  const unsigned lds0=(unsigned)(uintptr_t)shm;
  float*wsf=(float*)(shm+LDS_WS)+wid*64;
  const bf16*ksrc=Kh+(long)lane*KP+wid*8;
  const bf16*vsrc=Vh+(long)(16*(wid&3)+(lane>>2))*KP+(wid>>2)*32+(lane&3)*8;
  const unsigned kdst=lds0+LDS_K+wid*1024, vdst=lds0+LDS_V+wid*1024;
  #define DMA_K(t,slot) glds16(ksrc+(long)(t)*KVBLK*KP,(unsigned)__builtin_amdgcn_readfirstlane(kdst+(slot)))
  #define DMA_V(t,slot) glds16(vsrc+(long)(t)*KVBLK*KP,(unsigned)__builtin_amdgcn_readfirstlane(vdst+(slot)))
  const int vb0=(int)(lds0+LDS_V)+((lane>>4)&1)*32+(lane&3)*8+(4*hi+((lane&15)>>2))*64;
  const char*Kbase=shm+LDS_K; bf16x8 kf[8];
  const lds_cptr shm3=(lds_cptr)shm; const lds_cptr kp0=shm3+LDS_K+hi*1024+r32*16; const lds_cptr vp0=shm3+LDS_V+((lane>>4)&1)*32+(lane&3)*8+(4*hi+((lane&15)>>2))*64;
  const int NT=(q0+QB)/KVBLK;
  DMA_K(0,0);DMA_V(0,0);DMA_K(1,SLOTB);
  bf16x8 qr[4];
  #pragma unroll
  for(int d0=0;d0<4;++d0)qr[d0]=*reinterpret_cast<const bf16x8*>(&Qw[(long)r32*KP+d0*16+hi*8]);
  float mhat=0.f,l_reg=0.f;f32x16 o[2];o[0]=f32x16{};o[1]=f32x16{};f32x16 negm=f32x16{};asm volatile("":"+v"(negm));
  const int qrel=wid*QBLK+r32;
  #define CMASK(P0,P1,t) do{int jb_=(t)-(NT-4); if(jb_>=0)cmask(P0,P1,jb_,qrel,hi);}while(0)
  bool resc=false;
  #define START(P0,P1) do{ const float rm=rowmax(P0,P1); resc=false; \
    { const float dl=rm; mhat=fadd_s(mhat,dl); \
      _Pragma("unroll") for(int r=0;r<16;++r){P0[r]=fsub_s(P0[r],dl);P1[r]=fsub_s(P1[r],dl);} \
      _Pragma("unroll") for(int r=0;r<16;++r)negm[r]=-mhat; asm volatile("":"+v"(negm)); } \
    _Pragma("unroll") for(int r=0;r<16;++r)P0[r]=__builtin_amdgcn_exp2f(P0[r]); }while(0)
  #define RESC() do{ if(resc){ asm volatile("s_waitcnt lgkmcnt(0)":::"memory"); \
      _Pragma("unroll") for(int d_=0;d_<2;++d_) _Pragma("unroll") for(int r=0;r<16;++r)o[d_][r]*=wsf[crow(r,hi)]; } }while(0)
  f32x16 pA0,pA1,pB0,pB1;
  int sl_prev=0,sl_cur=0,sl_next=SLOTB;
  #define ROT() do{sl_prev=sl_cur;sl_cur=sl_next;sl_next=(sl_next==(NSLOT-1)*SLOTB)?0:sl_next+SLOTB;}while(0)
  DMA_K(2,2*SLOTB);
  WAIT_BAR(3);
  qkt(pA0,pA1,Kbase,qr,negm,r32,hi);asm volatile("s_nop 15\n\ts_nop 7":"+v"(pA0),"+v"(pA1));CMASK(pA0,pA1,0);
  START(pA0,pA1);
  _Pragma("unroll") for(int r=0;r<16;++r)pA1[r]=__builtin_amdgcn_exp2f(pA1[r]);
  WAIT_BAR(0);
  DMA_K(3,0);DMA_V(1,SLOTB);
  ROT();
  kload8(kf,kp0+sl_cur);
  WAIT_BAR(2);
  s16x4 vlo[8],vhi[8]; u32x4 pw0,pw1,pw2,pw3;
  #define PKW(P,B) cvtpk_s(P[B],P[B+1])
  #define PAF(k) __builtin_bit_cast(bf16x8,pw##k)
  #define VFR(i) (bf16x8){vlo[i][0],vlo[i][1],vlo[i][2],vlo[i][3],vhi[i][0],vhi[i][1],vhi[i][2],vhi[i][3]}
  #define PIN(x) asm volatile("":"+v"(x))
  #define MX3(a,b,c) __builtin_fmaxf(__builtin_fmaxf((a),(b)),(c))
  #define GAPA(MF,A0,A1,A2,A3,W0,W1,PW) do{ MF; sacc+=A0; sacc+=A1; sacc+=A2; sacc+=A3; PIN(sacc); W0; W1; PIN(PW); SBAR(); }while(0)
  #define EX(v) __builtin_amdgcn_exp2f(v)
  #define GAPB(MF,X,B) do{ MF; X[B]=EX(X[B]); X[B+1]=EX(X[B+1]); X[B+2]=EX(X[B+2]); X[B+3]=EX(X[B+3]); PIN(X); SBAR(); }while(0)
  #define VRD(i) do{ vlo[i]=vtr(vp_+(((i)>>2)*4096+((i)&3)*1024)); vhi[i]=vtr(vp_+(((i)>>2)*4096+((i)&3)*1024+512)); }while(0)
  #define KRD(G,j) do{ if(G){ kload2(kf,kp0+sl_next,j); SBAR(); } }while(0)
  #define STEP(C0,C1,P0,P1,t,GK,GV,GL) do{ SBAR(); \
    const lds_cptr vp_=vp0+sl_prev; \
    VRD(0); SBAR(); float sacc=(P0[0]+P0[1]); \
    GAPA(C0=__builtin_amdgcn_mfma_f32_32x32x16_bf16(kf[0],qr[0],negm,0,0,0), P0[2],P0[3],P0[4],P0[5],     pw0[0]=PKW(P0,0), pw0[1]=PKW(P0,2), pw0); \
    VRD(4); SBAR(); GAPA(C1=__builtin_amdgcn_mfma_f32_32x32x16_bf16(kf[1],qr[0],negm,0,0,0), P0[6],P0[7],P0[8],P0[9],     pw0[2]=PKW(P0,4), pw0[3]=PKW(P0,6), pw0); \
    VRD(1); SBAR(); GAPA(C0=__builtin_amdgcn_mfma_f32_32x32x16_bf16(kf[2],qr[1],C0,0,0,0),   P0[10],P0[11],P0[12],P0[13], pw1[0]=PKW(P0,8), pw1[1]=PKW(P0,10), pw1); \
    VRD(5); SBAR(); GAPA(C1=__builtin_amdgcn_mfma_f32_32x32x16_bf16(kf[3],qr[1],C1,0,0,0),   P0[14],P0[15],P1[0],P1[1],   pw1[2]=PKW(P0,12),pw1[3]=PKW(P0,14), pw1); \
    VRD(2); SBAR(); GAPA(C0=__builtin_amdgcn_mfma_f32_32x32x16_bf16(kf[4],qr[2],C0,0,0,0),   P1[2],P1[3],P1[4],P1[5],     pw2[0]=PKW(P1,0), pw2[1]=PKW(P1,2), pw2); \
    VRD(6); SBAR(); GAPA(C1=__builtin_amdgcn_mfma_f32_32x32x16_bf16(kf[5],qr[2],C1,0,0,0),   P1[6],P1[7],P1[8],P1[9],     pw2[2]=PKW(P1,4), pw2[3]=PKW(P1,6), pw2); \
    VRD(3); SBAR(); GAPA(C0=__builtin_amdgcn_mfma_f32_32x32x16_bf16(kf[6],qr[3],C0,0,0,0),   P1[10],P1[11],P1[12],P1[13], pw3[0]=PKW(P1,8), pw3[1]=PKW(P1,10), pw3); \
    VRD(7); SBAR(); GAPA(C1=__builtin_amdgcn_mfma_f32_32x32x16_bf16(kf[7],qr[3],C1,0,0,0),   P1[14],P1[15],0.f,0.f,       pw3[2]=PKW(P1,12),pw3[3]=PKW(P1,14), pw3); \
    l_reg+=sacc; \
    if(GK){DMA_K((t)+3,sl_cur);} if(GV){DMA_V((t)+1,sl_next);} \
    CMASK(C0,C1,t); \
    { float a=MX3(C0[0],C0[1],C1[0]),b=MX3(C0[2],C0[3],C1[1]); a=MX3(a,C1[2],C1[3]); \
      _Pragma("unroll") for(int r=4;r<16;r+=4){a=MX3(a,C0[r],C0[r+1]);b=MX3(b,C0[r+2],C0[r+3]);a=MX3(a,C1[r],C1[r+1]);b=MX3(b,C1[r+2],C1[r+3]);} \
      float rm=__builtin_fmaxf(a,b); { auto rr=__builtin_amdgcn_permlane32_swap(__float_as_uint(rm),__float_as_uint(rm),false,false); rm=__builtin_fmaxf(__uint_as_float(rr[0]),__uint_as_float(rr[1])); } \
      resc=false; \
      if(__builtin_expect(__any(rm>(float)THRL),0)){ const float dl=__builtin_fmaxf(rm,0.f); mhat+=dl; \
        _Pragma("unroll") for(int r=0;r<16;++r){C0[r]-=dl;C1[r]-=dl;} \
        _Pragma("unroll") for(int r=0;r<16;++r)negm[r]=-mhat; asm volatile("":"+v"(negm)); \
        const float f=__builtin_amdgcn_exp2f(-dl); l_reg*=f; if(hi==0)wsf[r32]=f; resc=true; } } \
    SBAR(); \
    GAPB(o[0]=__builtin_amdgcn_mfma_f32_32x32x16_bf16(PAF(0),VFR(0),o[0],0,0,0), C0,0); \
    GAPB(o[1]=__builtin_amdgcn_mfma_f32_32x32x16_bf16(PAF(0),VFR(4),o[1],0,0,0), C0,4); \
    KRD(GL,0); GAPB(o[0]=__builtin_amdgcn_mfma_f32_32x32x16_bf16(PAF(1),VFR(1),o[0],0,0,0), C0,8); \
    KRD(GL,1); GAPB(o[1]=__builtin_amdgcn_mfma_f32_32x32x16_bf16(PAF(1),VFR(5),o[1],0,0,0), C0,12); \
    KRD(GL,2); GAPB(o[0]=__builtin_amdgcn_mfma_f32_32x32x16_bf16(PAF(2),VFR(2),o[0],0,0,0), C1,0); \
    KRD(GL,3); GAPB(o[1]=__builtin_amdgcn_mfma_f32_32x32x16_bf16(PAF(2),VFR(6),o[1],0,0,0), C1,4); \
    GAPB(o[0]=__builtin_amdgcn_mfma_f32_32x32x16_bf16(PAF(3),VFR(3),o[0],0,0,0), C1,8); \
    GAPB(o[1]=__builtin_amdgcn_mfma_f32_32x32x16_bf16(PAF(3),VFR(7),o[1],0,0,0), C1,12); \
    }while(0)
  int t=1;
  #undef CMASK
  #define CMASK(P0,P1,t) do{}while(0)
  for(;t+5<NT;t+=2){
    STEP(pB0,pB1,pA0,pA1,t,true,true,true);     WAIT_BAR(2); RESC(); ROT();
    STEP(pA0,pA1,pB0,pB1,t+1,true,true,true);   WAIT_BAR(2); RESC(); ROT();
  }
  #undef CMASK
  #define CMASK(P0,P1,t) do{int jb_=(t)-(NT-4); if(jb_>=0)cmask(P0,P1,jb_,qrel,hi);}while(0)
  #define ENDW(tt) do{ if((tt)+3<NT){WAIT_BAR(2);} else if((tt)+2<NT){WAIT_BAR(1);} else {WAIT_BAR(0);} }while(0)
  for(;t+1<NT;t+=2){
    STEP(pB0,pB1,pA0,pA1,t,(t+3<NT),(t+1<NT),(t+1<NT));       ENDW(t);   RESC(); ROT();
    STEP(pA0,pA1,pB0,pB1,t+1,(t+4<NT),(t+2<NT),(t+2<NT));     ENDW(t+1); RESC(); ROT();
  }
  STEP(pB0,pB1,pA0,pA1,NT-1,false,false,false); RESC();
  { float sacc=pB0[0]+pB0[1]; _Pragma("unroll") for(int r=2;r<16;++r)sacc+=pB0[r]; _Pragma("unroll") for(int r=0;r<16;++r)sacc+=pB1[r]; l_reg+=sacc;
    pw0=(u32x4){PKW(pB0,0),PKW(pB0,2),PKW(pB0,4),PKW(pB0,6)};pw1=(u32x4){PKW(pB0,8),PKW(pB0,10),PKW(pB0,12),PKW(pB0,14)};pw2=(u32x4){PKW(pB1,0),PKW(pB1,2),PKW(pB1,4),PKW(pB1,6)};pw3=(u32x4){PKW(pB1,8),PKW(pB1,10),PKW(pB1,12),PKW(pB1,14)};
    SBAR(); pv(o,vb0+sl_cur,PAF(0),PAF(1),PAF(2),PAF(3)); }
  #undef PKW
  #undef PAF
  #undef VFR
  #undef PIN
  #undef MX3
  #undef GAPA
  #undef GAPB
  #undef EX
  #undef VRD
  #undef KRD
  #undef STEP
  #undef ENDW
  {auto rr=__builtin_amdgcn_permlane32_swap(__float_as_uint(l_reg),__float_as_uint(l_reg),false,false);l_reg=__uint_as_float(rr[0])+__uint_as_float(rr[1]);}
  if(hi==0)wsf[32+r32]=l_reg;asm volatile("s_waitcnt lgkmcnt(0)":::"memory");
  float rli[16];
  #pragma unroll
  for(int r=0;r<16;++r)rli[r]=__builtin_amdgcn_rcpf(wsf[32+crow(r,hi)]);
  bf16*Ow=O+(rowbase+q0+wid*QBLK)*OP+ocol;
  { bf16*stg=(bf16*)(shm+LDS_OST)+wid*2048;
    #pragma unroll
    for(int r=0;r<16;++r){const int orow=crow(r,hi);
      #pragma unroll
      for(int d0=0;d0<2;++d0)stg[orow*64+d0*32+r32]=__float2bfloat16(o[d0][r]*rli[r]);}
    asm volatile("s_waitcnt lgkmcnt(0)":::"memory");
    #pragma unroll
    for(int i=0;i<4;++i){const int row=i*8+(lane>>3),ch=lane&7; const u32x4 v=*(const u32x4*)(stg+row*64+ch*8); ATTN_STORE16(Ow+(long)row*OP+ch*8,v);} }
  asm volatile("s_waitcnt lgkmcnt(0)\n\ts_barrier":::"memory");
  #undef DMA_K
  #undef DMA_V
  #undef CMASK
  #undef START
  #undef RESC
  #undef ROT
}
constexpr int ATTN_LDS_BYTES=LDS_BYTES;
struct AttnTensors { const bf16* Q; const bf16* K; const bf16* V; bf16* O; };
struct AttnUnit { int bvh; int qb; };
struct StaticOrder {
  int vcu;
  __device__ __forceinline__ explicit StaticOrder(int grid,int block):vcu((block%8)*(grid/8)+block/8){}
  __device__ __forceinline__ bool next(int i,AttnUnit&u)const{ if(i>=4)return false; const int s=vcu&3; u.bvh=vcu>>2; u.qb=(i==0)?s:(i==1)?7-s:(i==2)?8+s:15-s; return true; }
  __device__ __forceinline__ void a_ready(const AttnUnit&)const{}
  __device__ __forceinline__ void done(const AttnUnit&)const{}
};
template<class Sched,int THRL=8> __device__ __forceinline__ void attn_phase(char*lds,const AttnTensors&T,const Sched&S){
  AttnUnit u;
  for(int i=0;S.next(i,u);++i){ S.a_ready(u); const int vh=u.bvh&15,hc=(vh>>1)*64;
    attn_unit<THRL>(u.bvh>>4,hc,hc,(vh>>2)*128+(vh&1)*64,vh*64,u.qb,T.Q,T.K,T.V,T.O,lds); S.done(u); }
}
#undef SBAR
#undef WAIT_BAR
}
#define GAS __attribute__((address_space(1)))
#define LAS __attribute__((address_space(3)))
typedef unsigned short bf16;
typedef unsigned v4u __attribute__((ext_vector_type(4)));
typedef float f32x4 __attribute__((ext_vector_type(4)));
typedef short bf16x8 __attribute__((ext_vector_type(8)));
typedef GAS unsigned gu32;
typedef GAS unsigned long long gu64;
#define RLX_AGENT __ATOMIC_RELAXED, __HIP_MEMORY_SCOPE_AGENT
#define LDS_WAIT() asm volatile("s_waitcnt lgkmcnt(0)" ::: "memory")
#define VM_WAIT() asm volatile("s_waitcnt vmcnt(0)" ::: "memory")
__device__ __forceinline__ unsigned long long rt() { return __builtin_amdgcn_s_memrealtime(); }
__device__ __forceinline__ unsigned f2bf(float f) { unsigned u = __builtin_bit_cast(unsigned, f); return (u + 0x7fffu + ((u >> 16) & 1u)) >> 16; }
__device__ __forceinline__ unsigned pk2(float lo, float hi) { return f2bf(lo) | (f2bf(hi) << 16); }

#define XB_TMO      128
#define XB_XCNT(j)  (256  + 64 * (j))
#define XB_XSUB(j)  (1280 + 64 * (j))
#define XB_XGEN(j)  (2304 + 64 * (j))
#define XB_TOP      3328
#define XB_TOPGEN   3392
#define XCD_BAR_WORDS 3456
#define XB_SPIN_CAP (1u << 18)

__device__ __forceinline__ unsigned xb_ld(unsigned* p)              { return __hip_atomic_load(p, __ATOMIC_RELAXED, __HIP_MEMORY_SCOPE_AGENT); }
__device__ __forceinline__ unsigned xb_add(unsigned* p, unsigned v) { return __hip_atomic_fetch_add(p, v, __ATOMIC_RELAXED, __HIP_MEMORY_SCOPE_AGENT); }
__device__ __forceinline__ unsigned xb_xcc_id() { return (unsigned)__builtin_amdgcn_s_getreg((3 << 11) | 20) & 0xFu; }
#define XB_SPIN(cond, bar) do { unsigned _sp = 0; while (cond) { __builtin_amdgcn_s_sleep(1); \
    if ((++_sp & 255u) == 0u) { if (xb_ld(&(bar)[XB_TMO])) break; if (_sp > XB_SPIN_CAP) { atomicAdd(&(bar)[XB_TMO], 1u); break; } } } } while (0)

struct XcdBarrier {
    unsigned* bar; unsigned x;
    volatile LAS unsigned* st;
};

__device__ __forceinline__ XcdBarrier xcd_barrier_post(unsigned* bar, volatile LAS unsigned* st) {
    XcdBarrier b; b.bar = bar; b.x = xb_xcc_id(); b.st = st;
    if (threadIdx.x == 0) (void)xb_add(&bar[XB_XCNT(b.x)], 1u);
    return b;
}
__device__ __forceinline__ void xcd_barrier_complete(unsigned* bar, unsigned x, unsigned& nloc, unsigned& nx) {
    const unsigned G = gridDim.x * gridDim.y * gridDim.z;
    unsigned sum, cnt, mine, sp = 0u;
    for (;;) {
        sum = 0u; cnt = 0u; mine = 0u;
#pragma unroll
        for (unsigned j = 0; j < 16; ++j) { const unsigned c = xb_ld(&bar[XB_XCNT(j)]); sum += c; cnt += (c > 0u) ? 1u : 0u; mine = (j == x) ? c : mine; }
        if (sum == G) break;
        __builtin_amdgcn_s_sleep(1);
        if ((++sp & 255u) == 0u) { if (xb_ld(&bar[XB_TMO])) break; if (sp > XB_SPIN_CAP) { atomicAdd(&bar[XB_TMO], 1u); break; } }
    }
    nloc = mine > 0u ? mine : 1u; nx = cnt > 0u ? cnt : 1u;
}

__device__ __forceinline__ void xcd_barrier(const XcdBarrier& b) {
    asm volatile("s_waitcnt vmcnt(0)" ::: "memory");
    __syncthreads();
    if (threadIdx.x == 0) {
        unsigned* bar = b.bar;
        __builtin_amdgcn_s_waitcnt(0);
        unsigned nloc = b.st[0], nx = b.st[1];
        if (nloc == 0u) { xcd_barrier_complete(bar, b.x, nloc, nx); b.st[0] = nloc; b.st[1] = nx; }
        const unsigned old = xb_add(&bar[XB_XSUB(b.x)], 1u);
        const unsigned gen = old / nloc;
        if (old + 1u == (gen + 1u) * nloc) {
            __builtin_amdgcn_fence(__ATOMIC_RELEASE, "agent");
            asm volatile("s_waitcnt vmcnt(0)" ::: "memory");
            const unsigned og = xb_add(&bar[XB_TOP], 1u);
            const unsigned tg = og / nx;
            if (og + 1u == (tg + 1u) * nx) xb_add(&bar[XB_TOPGEN], 1u);
            else XB_SPIN(xb_ld(&bar[XB_TOPGEN]) == tg, bar);
            __builtin_amdgcn_fence(__ATOMIC_ACQUIRE, "agent");
            xb_add(&bar[XB_XGEN(b.x)], 1u);
            asm volatile("s_waitcnt vmcnt(0)" ::: "memory");
        } else {
            XB_SPIN(xb_ld(&bar[XB_XGEN(b.x)]) == gen, bar);
            __builtin_amdgcn_fence(__ATOMIC_ACQUIRE, "agent");
            asm volatile("s_waitcnt vmcnt(0)" ::: "memory");
        }
    }
    __syncthreads();
}
constexpr int NWAVES = 8;
constexpr int MP = 16384, MS = 256, M = MP + MS;
constexpr int D = 1024, FF = 2816, INC = 4608;
constexpr float RMS_EPS = 1e-6f, LN_EPS = 1e-5f;
constexpr float QSCALE = 0.125f * 1.4426950408889634f;
constexpr int DEC_NS = 8;
constexpr size_t O_Y = 0, O_KP = 17039360, O_VP = 25427968, O_SP = 33816576, O_KS = 34078720, O_VS = 34209792, O_SS = 34340864, O_END = 34471936;
constexpr size_t KiB = 1024, MiB = 1u << 20;
constexpr size_t WS_CTL = 0, CTL_ZERO_BYTES = 1 * MiB;
constexpr size_t WS_W1T = 1 * MiB;
constexpr size_t WS_W2T = WS_W1T + (size_t)5632 * 1024 * 2;
constexpr size_t WS_WINT = WS_W2T + (size_t)1024 * 2816 * 2;
constexpr size_t WS_WPAT = WS_WINT + (size_t)4608 * 1024 * 2;
constexpr size_t WS_WPBT = WS_WPAT + (size_t)1024 * 512 * 2;
constexpr size_t WS_WOT = WS_WPBT + (size_t)1024 * 512 * 2;
constexpr size_t WS_W3T = WS_WOT + (size_t)1024 * 1024 * 2;
constexpr size_t WS_W4T = WS_W3T + (size_t)5632 * 1024 * 2;
constexpr size_t WS_XB = WS_W4T + (size_t)1024 * 2816 * 2;
constexpr size_t WS_SSX = WS_XB + (size_t)M * 1024 * 2;
constexpr size_t WS_ACT = WS_SSX + (size_t)M * 16 * 4;
constexpr size_t WS_H = WS_ACT + (size_t)M * 2816 * 2;
constexpr size_t WS_HB = WS_H + (size_t)M * 1024 * 4;
constexpr size_t WS_SSH = WS_HB + (size_t)M * 1024 * 2;
constexpr size_t WS_QB = WS_SSH + (size_t)M * 16 * 4;
constexpr size_t WS_KB = WS_QB + (size_t)M * 512 * 2;
constexpr size_t WS_VB = WS_KB + (size_t)M * 512 * 2;
constexpr size_t WS_UG = WS_VB + (size_t)M * 512 * 2;
constexpr size_t WS_VG = WS_UG + (size_t)M * 512 * 2;
constexpr size_t WS_VGS = WS_VG + (size_t)M * 512 * 4;
constexpr size_t WS_GA = WS_VGS + (size_t)M * 16 * 4;
constexpr size_t WS_GB = WS_GA + (size_t)M * 1024 * 2;
constexpr size_t WS_OV = WS_GB + (size_t)M * 1024 * 2;
constexpr size_t WS_DP = WS_OV + (size_t)MP * 1024 * 2;
constexpr size_t WS_DML = WS_DP + (size_t)128 * DEC_NS * 16 * 128 * 4;
constexpr size_t WS_AS = WS_DML + (size_t)128 * DEC_NS * 16 * 2 * 4;
constexpr size_t WS_SG = WS_AS + (size_t)M * 512 * 2;
constexpr size_t WS_T1 = WS_SG + (size_t)M * 512 * 2;
constexpr size_t WS_MB = WS_T1 + (size_t)M * 1024 * 4;
constexpr size_t WS_SSO = WS_MB + (size_t)M * 1024 * 2;
constexpr size_t WS_LAM = WS_SSO + (size_t)M * 16 * 4;
constexpr size_t WS_OPT_END = WS_LAM + 256;
static_assert(WS_W1T % 256 == 0 && WS_XB % 256 == 0 && WS_ACT % 256 == 0 && WS_H % 256 == 0 && WS_QB % 256 == 0 && WS_VG % 256 == 0 && WS_OV % 256 == 0 && WS_DP % 256 == 0 && WS_AS % 256 == 0 && WS_T1 % 256 == 0 && WS_LAM % 256 == 0, "ws alignment");
constexpr int CW_BAR = 4096;
constexpr int RING_OFF = 0, RING_BYTES = 131072;
constexpr int LDSCTL_OFF = RING_BYTES, MISC_OFF = LDSCTL_OFF + 320;
constexpr int LDS_BYTES = 147456;
typedef unsigned u32x2v __attribute__((ext_vector_type(2)));
#define MFMA16(a, b, c) __builtin_amdgcn_mfma_f32_16x16x32_bf16(a, b, c, 0, 0, 0)
__device__ __forceinline__ float bf_lo(unsigned w) { return __uint_as_float(w << 16); }
__device__ __forceinline__ float bf_hi(unsigned w) { return __uint_as_float(w & 0xffff0000u); }
__device__ __forceinline__ float wave_sum(float v) {
#pragma unroll
    for (int o = 1; o < 64; o <<= 1) v += __shfl_xor(v, o);
    return v;
}
__device__ __forceinline__ void p0_item(const float* W, int ldw, int K, bf16* WT, const float* gain, LAS float* scr, int k0, int n0, int sc0, int lane) {
#pragma unroll 8
    for (int i = 0; i < 32; ++i) { const int kk = 2 * i + (lane >> 5); float w = W[(size_t)(k0 + kk) * ldw + sc0 + (lane & 31)]; if (gain) w *= gain[k0 + kk]; scr[kk * 33 + (lane & 31)] = w; }
    LDS_WAIT(); asm volatile("" ::: "memory");
    const int c = lane & 7;
#pragma unroll
    for (int j = 0; j < 4; ++j) { const int n = (lane >> 3) + 8 * j; const LAS float* s = scr + (8 * c) * 33 + n;
        v4u o; o.x = pk2(s[0 * 33], s[1 * 33]); o.y = pk2(s[2 * 33], s[3 * 33]); o.z = pk2(s[4 * 33], s[5 * 33]); o.w = pk2(s[6 * 33], s[7 * 33]);
        *(GAS v4u*)(WT + (size_t)(n0 + n) * K + k0 + 8 * c) = o; }
    LDS_WAIT(); asm volatile("" ::: "memory");
}
__device__ __forceinline__ bool p0_matrix(int& r, const float* W, int ldw, int K, int N, bf16* WT, const float* gain, bool swiglu, LAS float* scr, int lane) {
    const int nblk = N / 32, items = (K / 64) * nblk;
    if (r >= items) { r -= items; return false; }
    const int kb = r / nblk, nb = r % nblk, n0 = 32 * nb; const int sc0 = swiglu ? ((n0 >> 7) & 1) * 2816 + (n0 >> 8) * 128 + (n0 & 127) : n0;
    p0_item(W, ldw, K, WT, gain, scr, 64 * kb, n0, sc0, lane); return true;
}
struct P0Args { const float *xp, *xs, *n1, *f1i, *f1o, *nm, *w_in, *lq1, *lk1, *lq2, *lk2, *wpa, *wpb, *w_out, *n2, *f2i, *f2o; bf16 *W1T, *W2T, *WINT, *WPAT, *WPBT, *WOT, *W3T, *W4T, *XB; float *SSX, *LAM; };
__device__ __forceinline__ void p0_prologue(const P0Args& a, LAS unsigned char* lds, int wave, int lane, int vcu, int G) {
    LAS float* scr = (LAS float*)(lds + wave * 16384);
    const int gw = vcu * NWAVES + wave, NGW = G * NWAVES;
    constexpr int NITEMS = 2 * (16 * 176) + 2 * (44 * 32) + 16 * 144 + 2 * (8 * 32) + 16 * 32;
    for (int it = gw; it < NITEMS; it += NGW) {
        int r = it;
        if (p0_matrix(r, a.f1i, 5632, 1024, 5632, a.W1T, a.n1, true, scr, lane)) continue;
        if (p0_matrix(r, a.f2i, 5632, 1024, 5632, a.W3T, a.n2, true, scr, lane)) continue;
        if (p0_matrix(r, a.f1o, 1024, 2816, 1024, a.W2T, nullptr, false, scr, lane)) continue;
        if (p0_matrix(r, a.f2o, 1024, 2816, 1024, a.W4T, nullptr, false, scr, lane)) continue;
        if (p0_matrix(r, a.w_in, 4608, 1024, 4608, a.WINT, a.nm, false, scr, lane)) continue;
        if (p0_matrix(r, a.wpa, 1024, 512, 1024, a.WPAT, nullptr, false, scr, lane)) continue;
        if (p0_matrix(r, a.wpb, 1024, 512, 1024, a.WPBT, nullptr, false, scr, lane)) continue;
        p0_matrix(r, a.w_out, 1024, 1024, 1024, a.WOT, nullptr, false, scr, lane);
    }
    for (int m = gw; m < M; m += NGW) {
        const float* xr = (m < MP) ? a.xp + (size_t)m * D : a.xs + (size_t)(m - MP) * D;
        const GAS f32x4* xv = (const GAS f32x4*)xr + lane; f32x4 v[4]; float s = 0.f;
#pragma unroll
        for (int j = 0; j < 4; ++j) { v[j] = xv[64 * j]; s += (v[j][0] * v[j][0] + v[j][1] * v[j][1]) + (v[j][2] * v[j][2] + v[j][3] * v[j][3]); }
        s = wave_sum(s);
        GAS unsigned long long* o8 = (GAS unsigned long long*)(a.XB + (size_t)m * D) + lane;
#pragma unroll
        for (int j = 0; j < 4; ++j) o8[64 * j] = (unsigned long long)pk2(v[j][0], v[j][1]) | ((unsigned long long)pk2(v[j][2], v[j][3]) << 32);
        if (lane < 16) a.SSX[(size_t)m * 16 + lane] = (lane == 0) ? s : 0.f;
    }
    if (vcu == 0 && wave == 0 && lane == 0) { float s1 = 0.f, s2 = 0.f; for (int i = 0; i < 64; ++i) { s1 += a.lq1[i] * a.lk1[i]; s2 += a.lq2[i] * a.lk2[i]; } a.LAM[0] = expf(s1) - expf(s2) + 0.2f; }
}
__device__ __forceinline__ void decode_unit(int b, int h, int sp, const bf16* QB, const float* cache_k, const float* cache_v, const int* pt, float* DP, float* DML, LAS unsigned char* lds, int tid) {
    const int lane = tid & 63, wid = __builtin_amdgcn_readfirstlane(tid >> 6), j = lane & 15, g = lane >> 4;
    LAS unsigned char* wl = lds + wid * 10240;
    bf16x8 qf[4];
#pragma unroll
    for (int s = 0; s < 4; ++s) { qf[s] = (bf16x8){0, 0, 0, 0, 0, 0, 0, 0};
        if ((j >> 3) == (s >> 1)) qf[s] = *(const bf16x8*)(QB + (size_t)(MP + b * 8 + (j & 7)) * 512 + h * 128 + s * 32 + g * 8); }
    const int page = __builtin_amdgcn_readfirstlane(pt[b * 64 + sp * 8 + wid]);
    const float* kbase = cache_k + ((size_t)page * 512 + h) * 128 + (lane >> 5) * 16 * 512 + (lane & 31) * 4;
    const float* vbase = cache_v + ((size_t)page * 512 + h) * 128 + (lane >> 5) * 16 * 512 + (lane & 31) * 4;
    f32x4 kreg[16], vreg[16];
#define DEC_ISSUE(reg, base, blk) do { _Pragma("unroll") for (int i_ = 0; i_ < 16; ++i_) reg[i_] = __builtin_nontemporal_load((const f32x4*)((base) + (size_t)((blk) * 32 + i_) * 512)); } while (0)
    DEC_ISSUE(kreg, kbase, 0); DEC_ISSUE(vreg, vbase, 0);
    float m_run = -INFINITY, l_run = 0.f; f32x4 o[8];
#pragma unroll
    for (int cb = 0; cb < 8; ++cb) o[cb] = (f32x4){0.f, 0.f, 0.f, 0.f};
#pragma unroll 1
    for (int blk = 0; blk < 4; ++blk) {
#pragma unroll
        for (int i = 0; i < 16; ++i) { u32x2v w; w.x = pg8::cvt_pk_bf16(kreg[i][0], kreg[i][1]); w.y = pg8::cvt_pk_bf16(kreg[i][2], kreg[i][3]);
            *(LAS u32x2v*)(wl + ((lane >> 5) * 16 + i) * 272 + (lane & 31) * 8) = w; }
        if (blk < 3) DEC_ISSUE(kreg, kbase, blk + 1);
        f32x4 S[2];
#pragma unroll
        for (int T = 0; T < 2; ++T) { S[T] = (f32x4){0.f, 0.f, 0.f, 0.f};
#pragma unroll
            for (int s = 0; s < 4; ++s) { const bf16x8 kf = *(const LAS bf16x8*)(wl + (16 * T + j) * 272 + s * 64 + g * 16); S[T] = MFMA16(kf, qf[s], S[T]); } }
        float bm = fmaxf(fmaxf(fmaxf(S[0][0], S[0][1]), fmaxf(S[0][2], S[0][3])), fmaxf(fmaxf(S[1][0], S[1][1]), fmaxf(S[1][2], S[1][3])));
        bm = fmaxf(bm, __shfl_xor(bm, 16)); bm = fmaxf(bm, __shfl_xor(bm, 32));
        const float m_new = fmaxf(m_run, bm), alpha = __builtin_amdgcn_exp2f(m_run - m_new); m_run = m_new;
        float ps = 0.f;
#pragma unroll
        for (int T = 0; T < 2; ++T)
#pragma unroll
            for (int e = 0; e < 4; ++e) { S[T][e] = __builtin_amdgcn_exp2f(S[T][e] - m_new); ps += S[T][e]; }
        l_run = l_run * alpha + ps;
#pragma unroll
        for (int cb = 0; cb < 8; ++cb) o[cb] = o[cb] * alpha;
        v4u pw; pw.x = pg8::cvt_pk_bf16(S[0][0], S[0][1]); pw.y = pg8::cvt_pk_bf16(S[0][2], S[0][3]); pw.z = pg8::cvt_pk_bf16(S[1][0], S[1][1]); pw.w = pg8::cvt_pk_bf16(S[1][2], S[1][3]);
        const bf16x8 pf = __builtin_bit_cast(bf16x8, pw);
#pragma unroll
        for (int gk = 0; gk < 4; ++gk)
#pragma unroll
            for (int cc = 0; cc < 4; ++cc) { u32x2v w; w.x = pg8::cvt_pk_bf16(vreg[4 * gk][cc], vreg[4 * gk + 1][cc]); w.y = pg8::cvt_pk_bf16(vreg[4 * gk + 2][cc], vreg[4 * gk + 3][cc]);
                *(LAS u32x2v*)(wl + (4 * (lane & 31) + cc) * 80 + (8 * gk + 4 * (lane >> 5)) * 2) = w; }
        if (blk < 3) DEC_ISSUE(vreg, vbase, blk + 1);
#pragma unroll
        for (int cb = 0; cb < 8; ++cb) { const bf16x8 vf = *(const LAS bf16x8*)(wl + (16 * cb + j) * 80 + g * 16); o[cb] = MFMA16(vf, pf, o[cb]); }
    }
#undef DEC_ISSUE
    l_run += __shfl_xor(l_run, 16); l_run += __shfl_xor(l_run, 32);
    __syncthreads();
    LAS float* cw = (LAS float*)lds;
#pragma unroll
    for (int cb = 0; cb < 8; ++cb) *(LAS f32x4*)(cw + (wid * 16 + j) * 132 + 16 * cb + 4 * g) = o[cb];
    if (g == 0) { cw[(wid * 16 + j) * 132 + 128] = m_run; cw[(wid * 16 + j) * 132 + 129] = l_run; }
    __syncthreads();
    { const int q = tid >> 5, c4 = (tid & 31) * 4; float mw[8]; float Mx = -INFINITY;
#pragma unroll
        for (int w = 0; w < 8; ++w) { mw[w] = cw[(w * 16 + q) * 132 + 128]; Mx = fmaxf(Mx, mw[w]); }
        f32x4 acc = (f32x4){0.f, 0.f, 0.f, 0.f}; float L = 0.f;
#pragma unroll
        for (int w = 0; w < 8; ++w) { const float f = __builtin_amdgcn_exp2f(mw[w] - Mx); acc += *(const LAS f32x4*)(cw + (w * 16 + q) * 132 + c4) * f; L += cw[(w * 16 + q) * 132 + 129] * f; }
        const int unit = (b * 4 + h) * DEC_NS + sp;
        *(f32x4*)(DP + ((size_t)unit * 16 + q) * 128 + c4) = acc;
        if ((tid & 31) == 0) { DML[((size_t)unit * 16 + q) * 2] = Mx; DML[((size_t)unit * 16 + q) * 2 + 1] = L; } }
    __syncthreads();
}
struct SpArgs { const float *VG, *VGS, *ln_g, *ln_b, *w_s, *b_s; const bf16* UG; bf16* SG; float* out; };
__device__ __forceinline__ void spatial_unit(int ck, int g, const SpArgs& a, LAS unsigned char* lds, int tid) {
    const int lane = tid & 63, wid = __builtin_amdgcn_readfirstlane(tid >> 6), j = lane & 15, gq = lane >> 4;
    LAS unsigned char* Wt = lds; LAS unsigned char* Vt = lds + 34816; LAS float* st = (LAS float*)(lds + 69632);
    const int R0 = ck * 128;
    if (tid < 128) { const f32x4* p = (const f32x4*)(a.VGS + (size_t)(R0 + tid) * 16); const f32x4 x0 = p[0], x1 = p[1], x2 = p[2], x3 = p[3];
        const float s1 = (x0[0] + x0[2]) + (x1[0] + x1[2]) + (x2[0] + x2[2]) + (x3[0] + x3[2]), s2 = (x0[1] + x0[3]) + (x1[1] + x1[3]) + (x2[1] + x2[3]) + (x3[1] + x3[3]);
        const float mean = s1 * (1.0f / 512.0f), var = s2 * (1.0f / 512.0f) - mean * mean; st[2 * tid] = mean; st[2 * tid + 1] = 1.0f / sqrtf(var + LN_EPS); }
#pragma unroll
    for (int i = 0; i < 8; ++i) { const int idx = tid + 512 * i, t = idx >> 5, s4 = (idx & 31) * 4; f32x4 w = *(const f32x4*)(a.w_s + ((size_t)g * 128 + t) * 128 + s4);
#pragma unroll
        for (int e = 0; e < 4; ++e) if (s4 + e > t) w[e] = 0.f;
        u32x2v p; p.x = pg8::cvt_pk_bf16(w[0], w[1]); p.y = pg8::cvt_pk_bf16(w[2], w[3]); *(LAS u32x2v*)(Wt + t * 272 + s4 * 2) = p; }
    __syncthreads();
    const bool tail = (ck & 31) == 31; const int bb = ck >> 5;
#pragma unroll
    for (int i = 0; i < 8; ++i) { const int idx = tid + 512 * i, s = idx >> 5, e4 = (idx & 31) * 4; const f32x4 x = *(const f32x4*)(a.VG + (size_t)(R0 + s) * 512 + g * 128 + e4);
        const float mean = st[2 * s], rstd = st[2 * s + 1]; const f32x4 gg = *(const f32x4*)(a.ln_g + g * 128 + e4), bv = *(const f32x4*)(a.ln_b + g * 128 + e4);
        const f32x4 v = (x - mean) * rstd * gg + bv;
        if (tail) *(f32x4*)(a.out + O_SP + ((size_t)bb * 128 + s) * 512 + g * 128 + e4) = v;
#pragma unroll
        for (int cc = 0; cc < 4; ++cc) *(LAS unsigned short*)(Vt + (e4 + cc) * 272 + s * 2) = (unsigned short)f2bf(v[cc]); }
    __syncthreads();
    f32x4 acc[8];
#pragma unroll
    for (int eb = 0; eb < 8; ++eb) acc[eb] = (f32x4){0.f, 0.f, 0.f, 0.f};
#pragma unroll
    for (int ks = 0; ks < 4; ++ks) { const bf16x8 wf = *(const LAS bf16x8*)(Wt + (16 * wid + j) * 272 + ks * 64 + gq * 16);
#pragma unroll
        for (int eb = 0; eb < 8; ++eb) { const bf16x8 vf = *(const LAS bf16x8*)(Vt + (16 * eb + j) * 272 + ks * 64 + gq * 16); acc[eb] = MFMA16(vf, wf, acc[eb]); } }
    { const int t = 16 * wid + j; const float bias = a.b_s[g * 128 + t]; const size_t ro = (size_t)(R0 + t) * 512 + g * 128 + 4 * gq;
#pragma unroll
        for (int eb = 0; eb < 8; ++eb) { const u32x2v ug = *(const u32x2v*)(a.UG + ro + 16 * eb); const f32x4 v = acc[eb] + bias;
            u32x2v w; w.x = pg8::cvt_pk_bf16(bf_lo(ug.x) * v[0], bf_hi(ug.x) * v[1]); w.y = pg8::cvt_pk_bf16(bf_lo(ug.y) * v[2], bf_hi(ug.y) * v[3]); *(u32x2v*)(a.SG + ro + 16 * eb) = w; } }
    __syncthreads();
}
__device__ __forceinline__ void spatial_sample_unit(int b, const SpArgs& a, int tid) {
    const int g = tid >> 7; float vs[8];
#pragma unroll
    for (int s = 0; s < 8; ++s) { const int row = MP + b * 8 + s; const f32x4* p = (const f32x4*)(a.VGS + (size_t)row * 16); const f32x4 x0 = p[0], x1 = p[1], x2 = p[2], x3 = p[3];
        const float s1 = (x0[0] + x0[2]) + (x1[0] + x1[2]) + (x2[0] + x2[2]) + (x3[0] + x3[2]), s2 = (x0[1] + x0[3]) + (x1[1] + x1[3]) + (x2[1] + x2[3]) + (x3[1] + x3[3]);
        const float mean = s1 * (1.0f / 512.0f), var = s2 * (1.0f / 512.0f) - mean * mean, rstd = 1.0f / sqrtf(var + LN_EPS);
        vs[s] = (a.VG[(size_t)row * 512 + tid] - mean) * rstd * a.ln_g[tid] + a.ln_b[tid];
        a.out[O_SS + (size_t)(b * 8 + s) * 512 + tid] = vs[s]; }
#pragma unroll
    for (int t = 0; t < 8; ++t) { float acc = a.b_s[g * 128 + t];
#pragma unroll
        for (int s = 0; s < 8; ++s) if (s <= t) acc += a.w_s[((size_t)g * 128 + t) * 128 + s] * vs[s];
        const size_t o = (size_t)(MP + b * 8 + t) * 512 + tid; const float ug = __uint_as_float((unsigned)a.UG[o] << 16);
        a.SG[o] = (bf16)f2bf(ug * acc); }
}
__device__ __forceinline__ void combine_prompt(const bf16* OV, const float* subln, float lam, bf16* AS, int gw, int NGW, int lane) {
    const int h = lane >> 4, q = lane & 15, e = q >> 3, d = (q & 7) * 8;
    const f32x4 g0 = *(const f32x4*)(subln + e * 64 + d), g1 = *(const f32x4*)(subln + e * 64 + d + 4);
    for (int m = gw; m < MP; m += NGW) {
        const v4u a1 = *(const v4u*)(OV + (size_t)m * 1024 + (h * 4 + e) * 64 + d), a2 = *(const v4u*)(OV + (size_t)m * 1024 + (h * 4 + 2 + e) * 64 + d);
        float o[8]; o[0] = bf_lo(a1.x) - lam * bf_lo(a2.x); o[1] = bf_hi(a1.x) - lam * bf_hi(a2.x); o[2] = bf_lo(a1.y) - lam * bf_lo(a2.y); o[3] = bf_hi(a1.y) - lam * bf_hi(a2.y);
        o[4] = bf_lo(a1.z) - lam * bf_lo(a2.z); o[5] = bf_hi(a1.z) - lam * bf_hi(a2.z); o[6] = bf_lo(a1.w) - lam * bf_lo(a2.w); o[7] = bf_hi(a1.w) - lam * bf_hi(a2.w);
        float ss = 0.f;
#pragma unroll
        for (int i = 0; i < 8; ++i) ss += o[i] * o[i];
        ss += __shfl_xor(ss, 1); ss += __shfl_xor(ss, 2); ss += __shfl_xor(ss, 4); ss += __shfl_xor(ss, 8);
        const float r = 0.8f / sqrtf(ss * (1.0f / 128.0f) + RMS_EPS);
        v4u w; w.x = pk2(o[0] * r * g0[0], o[1] * r * g0[1]); w.y = pk2(o[2] * r * g0[2], o[3] * r * g0[3]); w.z = pk2(o[4] * r * g1[0], o[5] * r * g1[1]); w.w = pk2(o[6] * r * g1[2], o[7] * r * g1[3]);
        *(v4u*)(AS + (size_t)m * 512 + h * 128 + e * 64 + d) = w;
    }
}
__device__ __forceinline__ void combine_sample(int b, int h, const bf16* QB, const float* out, const float* DP, const float* DML, const float* subln, float lam, bf16* AS, LAS unsigned char* lds, int tid) {
    const int q = tid >> 5, cg = tid & 31, c4 = cg * 4, c = q >> 3, t = q & 7;
    const unsigned qw = *(const unsigned*)(QB + (size_t)(MP + b * 8 + t) * 512 + h * 128 + c * 64 + 2 * cg); const float q0 = bf_lo(qw), q1 = bf_hi(qw);
    float sn[8];
#pragma unroll
    for (int t2 = 0; t2 < 8; ++t2) { const float* kp = out + O_KS + (size_t)(b * 8 + t2) * 512 + h * 128 + c * 64 + 2 * cg; float s = q0 * kp[0] + q1 * kp[1];
        s += __shfl_xor(s, 1); s += __shfl_xor(s, 2); s += __shfl_xor(s, 4); s += __shfl_xor(s, 8); s += __shfl_xor(s, 16); sn[t2] = (t2 <= t) ? s : -INFINITY; }
    const int unit0 = (b * 4 + h) * DEC_NS; float mw[DEC_NS], lw[DEC_NS]; float Mx = -INFINITY;
#pragma unroll
    for (int sp = 0; sp < DEC_NS; ++sp) { mw[sp] = DML[((size_t)(unit0 + sp) * 16 + q) * 2]; lw[sp] = DML[((size_t)(unit0 + sp) * 16 + q) * 2 + 1]; Mx = fmaxf(Mx, mw[sp]); }
#pragma unroll
    for (int t2 = 0; t2 < 8; ++t2) Mx = fmaxf(Mx, sn[t2]);
    f32x4 acc = (f32x4){0.f, 0.f, 0.f, 0.f}; float L = 0.f;
#pragma unroll
    for (int sp = 0; sp < DEC_NS; ++sp) { const float f = __builtin_amdgcn_exp2f(mw[sp] - Mx); acc += *(const f32x4*)(DP + ((size_t)(unit0 + sp) * 16 + q) * 128 + c4) * f; L += lw[sp] * f; }
#pragma unroll
    for (int t2 = 0; t2 < 8; ++t2) { const float p = __builtin_amdgcn_exp2f(sn[t2] - Mx); acc += *(const f32x4*)(out + O_VS + (size_t)(b * 8 + t2) * 512 + h * 128 + c4) * p; L += p; }
    LAS float* ol = (LAS float*)lds;
    *(LAS f32x4*)(ol + q * 128 + c4) = acc * (1.0f / L);
    __syncthreads();
    if (q < 8) { const f32x4 of = *(const LAS f32x4*)(ol + t * 128 + c4) - *(const LAS f32x4*)(ol + (8 + t) * 128 + c4) * lam;
        float ss = (of[0] * of[0] + of[1] * of[1]) + (of[2] * of[2] + of[3] * of[3]);
        ss += __shfl_xor(ss, 1); ss += __shfl_xor(ss, 2); ss += __shfl_xor(ss, 4); ss += __shfl_xor(ss, 8); ss += __shfl_xor(ss, 16);
        const float r = 0.8f / sqrtf(ss * (1.0f / 128.0f) + RMS_EPS); const f32x4 gsl = *(const f32x4*)(subln + c4);
        u32x2v w; w.x = pk2(of[0] * r * gsl[0], of[1] * r * gsl[1]); w.y = pk2(of[2] * r * gsl[2], of[3] * r * gsl[3]);
        *(u32x2v*)(AS + (size_t)(MP + b * 8 + t) * 512 + h * 128 + c4) = w; }
    __syncthreads();
}
__device__ __forceinline__ void final_norm(float* y, const float* ss, const float* nf, int gw, int NGW, int lane) {
    f32x4 gv[4];
#pragma unroll
    for (int jx = 0; jx < 4; ++jx) gv[jx] = *((const f32x4*)nf + lane + 64 * jx);
    for (int m = gw; m < M; m += NGW) { const f32x4* p = (const f32x4*)(ss + (size_t)m * 16); const f32x4 a = p[0], b = p[1], c = p[2], d = p[3];
        const float s = (pg8::hsum4(a) + pg8::hsum4(b)) + (pg8::hsum4(c) + pg8::hsum4(d)), r = 1.0f / sqrtf(s * (1.0f / 1024.0f) + RMS_EPS);
        f32x4* yr = (f32x4*)(y + (size_t)m * D) + lane;
#pragma unroll
        for (int jx = 0; jx < 4; ++jx) yr[64 * jx] = yr[64 * jx] * r * gv[jx]; }
}

struct Args { const void* in[26]; float* out; unsigned char* ws; int ph_lo, ph_hi; };
constexpr int N_PHASES = 11;
__global__ void __launch_bounds__(NWAVES * 64, 2) mega_fwd(Args args) {
    extern __shared__ __attribute__((aligned(16))) unsigned char lds_raw[];
    LAS unsigned char* lds = (LAS unsigned char*)lds_raw;
    const int tid = threadIdx.x, lane = tid & 63, wave = __builtin_amdgcn_readfirstlane(tid >> 6);
    const int G = gridDim.x; const int bx = blockIdx.x; const int vcu = (G % 8 == 0) ? (bx % 8) * (G / 8) + bx / 8 : bx;
    const int gw = vcu * NWAVES + wave, NGW = G * NWAVES;
    unsigned char* ws = args.ws; float* out = args.out;
    gu32* ctl = (gu32*)(ws + WS_CTL);
    const float* x_prompt = (const float*)args.in[0]; const float* x_sample = (const float*)args.in[1];
    const float* cache_k = (const float*)args.in[2]; const float* cache_v = (const float*)args.in[3]; const int* page_table = (const int*)args.in[4];
    bf16 *W1T = (bf16*)(ws + WS_W1T), *W2T = (bf16*)(ws + WS_W2T), *WINT = (bf16*)(ws + WS_WINT), *WPAT = (bf16*)(ws + WS_WPAT), *WPBT = (bf16*)(ws + WS_WPBT), *WOT = (bf16*)(ws + WS_WOT), *W3T = (bf16*)(ws + WS_W3T), *W4T = (bf16*)(ws + WS_W4T);
    bf16 *XB = (bf16*)(ws + WS_XB), *ACT = (bf16*)(ws + WS_ACT), *HB = (bf16*)(ws + WS_HB), *QB = (bf16*)(ws + WS_QB), *KB = (bf16*)(ws + WS_KB), *VB = (bf16*)(ws + WS_VB), *UG = (bf16*)(ws + WS_UG);
    bf16 *GA = (bf16*)(ws + WS_GA), *GB = (bf16*)(ws + WS_GB), *OV = (bf16*)(ws + WS_OV), *AS = (bf16*)(ws + WS_AS), *SG = (bf16*)(ws + WS_SG), *MB = (bf16*)(ws + WS_MB);
    float *SSX = (float*)(ws + WS_SSX), *H = (float*)(ws + WS_H), *SSH = (float*)(ws + WS_SSH), *VG = (float*)(ws + WS_VG), *VGS = (float*)(ws + WS_VGS), *DP = (float*)(ws + WS_DP), *DML = (float*)(ws + WS_DML);
    float *T1 = (float*)(ws + WS_T1), *SSO = (float*)(ws + WS_SSO), *LAM = (float*)(ws + WS_LAM);
    for (int u = tid; u < (LDS_BYTES - LDSCTL_OFF) / 4; u += NWAVES * 64) ((LAS unsigned*)(lds + LDSCTL_OFF))[u] = 0u;
    __syncthreads();
    const int lo = args.ph_lo, hi = args.ph_hi;
    const bool use_bar = (hi - lo) > 1;
    XcdBarrier bar; bar.bar = (unsigned*)(ctl + CW_BAR); bar.x = 0; bar.st = nullptr;
    if (use_bar) bar = xcd_barrier_post((unsigned*)(ctl + CW_BAR), (volatile LAS unsigned*)(lds + MISC_OFF) + 8);
#ifndef PHASE_MASK
#define PHASE_MASK 0x7ff
#endif
#define IN(k) (((PHASE_MASK >> (k)) & 1) && lo <= (k) && (k) < hi)
#define SEAM(k) do { if (IN(k) && IN((k) + 1)) xcd_barrier(bar); } while (0)

    if (IN(0)) {
        P0Args a; a.xp = x_prompt; a.xs = x_sample; a.n1 = (const float*)args.in[5]; a.f1i = (const float*)args.in[6]; a.f1o = (const float*)args.in[7]; a.nm = (const float*)args.in[8]; a.w_in = (const float*)args.in[9];
        a.lq1 = (const float*)args.in[10]; a.lk1 = (const float*)args.in[11]; a.lq2 = (const float*)args.in[12]; a.lk2 = (const float*)args.in[13];
        a.wpa = (const float*)args.in[19]; a.wpb = (const float*)args.in[20]; a.w_out = (const float*)args.in[21]; a.n2 = (const float*)args.in[22]; a.f2i = (const float*)args.in[23]; a.f2o = (const float*)args.in[24];
        a.W1T = W1T; a.W2T = W2T; a.WINT = WINT; a.WPAT = WPAT; a.WPBT = WPBT; a.WOT = WOT; a.W3T = W3T; a.W4T = W4T; a.XB = XB; a.SSX = SSX; a.LAM = LAM;
        p0_prologue(a, lds, wave, lane, vcu, G);
    }
    SEAM(0);
    if (IN(1)) { pg8::Gemm g{XB, W1T, M, 2 * FF, D}; pg8::StaticOrder S; S.init(M, 2 * FF, G, bx); pg8::EpiSwiglu E{ACT, SSX};
        pg8::gemm_phase<pg8::EpiSwiglu, pg8::StaticOrder, true, true>(lds + RING_OFF, g, S, E); }
    SEAM(1);
    if (IN(2)) { pg8::Gemm g{ACT, W2T, M, D, FF}; pg8::StaticOrder S; S.init(M, D, G, bx); pg8::EpiRes E{x_prompt, x_sample, H, HB, SSH, 0.5f};
        pg8::gemm_phase<pg8::EpiRes, pg8::StaticOrder, true, true>(lds + RING_OFF, g, S, E); }
    SEAM(2);
    if (IN(3)) { pg8::Gemm g{HB, WINT, M, INC, D}; pg8::StaticOrder S; S.init(M, INC, G, bx); pg8::EpiInProj E{SSH, QB, KB, VB, UG, GA, GB, VG, VGS, out, QSCALE};
        pg8::gemm_phase<pg8::EpiInProj, pg8::StaticOrder, true, true>(lds + RING_OFF, g, S, E); }
    SEAM(3);
    if (IN(4)) {
#ifndef P4_SUB
#define P4_SUB 15
#endif
        if ((P4_SUB & 1) && G == 256) { const attn_body::AttnTensors AT{(const attn_body::bf16*)QB, (const attn_body::bf16*)KB, (const attn_body::bf16*)VB, (attn_body::bf16*)OV}; const attn_body::StaticOrder S((int)G, (int)blockIdx.x); attn_body::attn_phase<attn_body::StaticOrder>((char*)lds_raw + RING_OFF, AT, S); }
        __syncthreads();
        if (P4_SUB & 2) for (int d = vcu; d < 128 * DEC_NS; d += G) decode_unit(d / (4 * DEC_NS), (d / DEC_NS) & 3, d % DEC_NS, QB, cache_k, cache_v, page_table, DP, DML, lds + RING_OFF, tid);
        SpArgs sa; sa.VG = VG; sa.VGS = VGS; sa.ln_g = (const float*)args.in[15]; sa.ln_b = (const float*)args.in[16]; sa.w_s = (const float*)args.in[17]; sa.b_s = (const float*)args.in[18]; sa.UG = UG; sa.SG = SG; sa.out = out;
        if (P4_SUB & 4) for (int s = vcu; s < 512; s += G) spatial_unit(s >> 2, s & 3, sa, lds + RING_OFF, tid);
        if (P4_SUB & 8) for (int s = vcu; s < 32; s += G) spatial_sample_unit(s, sa, tid);
    }
    SEAM(4);
    if (IN(5)) { const float lam = LAM[0]; const float* subln = (const float*)args.in[14];
        combine_prompt(OV, subln, lam, AS, gw, NGW, lane);
        for (int k = vcu; k < 128; k += G) combine_sample(k >> 2, k & 3, QB, out, DP, DML, subln, lam, AS, lds + RING_OFF, tid); }
    SEAM(5);
    if (IN(6)) {
        { pg8::Gemm g{AS, WPAT, M, D, 512}; pg8::StaticOrder S; S.init(M, D, G, bx); pg8::EpiGate1 E{GA, T1};
          pg8::gemm_phase<pg8::EpiGate1, pg8::StaticOrder, true, true>(lds + RING_OFF, g, S, E); }
        asm volatile("s_waitcnt vmcnt(0)" ::: "memory");
        { pg8::Gemm g{SG, WPBT, M, D, 512}; pg8::StaticOrder S; S.init(M, D, G, bx); pg8::EpiGate2 E{GB, T1, MB};
          pg8::gemm_phase<pg8::EpiGate2, pg8::StaticOrder, true, true>(lds + RING_OFF, g, S, E); }
    }
    SEAM(6);
    if (IN(7)) { pg8::Gemm g{MB, WOT, M, D, D}; pg8::StaticOrder S; S.init(M, D, G, bx); pg8::EpiRes E{H, H + (size_t)MP * D, H, HB, SSH, 1.0f};
        pg8::gemm_phase<pg8::EpiRes, pg8::StaticOrder, true, true>(lds + RING_OFF, g, S, E); }
    SEAM(7);
    if (IN(8)) { pg8::Gemm g{HB, W3T, M, 2 * FF, D}; pg8::StaticOrder S; S.init(M, 2 * FF, G, bx); pg8::EpiSwiglu E{ACT, SSH};
        pg8::gemm_phase<pg8::EpiSwiglu, pg8::StaticOrder, true, true>(lds + RING_OFF, g, S, E); }
    SEAM(8);
    if (IN(9)) { pg8::Gemm g{ACT, W4T, M, D, FF}; pg8::StaticOrder S; S.init(M, D, G, bx); pg8::EpiRes E{H, H + (size_t)MP * D, out + O_Y, nullptr, SSO, 0.5f};
        pg8::gemm_phase<pg8::EpiRes, pg8::StaticOrder, true, true>(lds + RING_OFF, g, S, E); }
    SEAM(9);
    if (IN(10)) final_norm(out + O_Y, SSO, (const float*)args.in[25], gw, NGW, lane);
#undef IN
#undef SEAM
}
extern "C" void kernel_launch(void* const* d_in, const int* in_sizes, int n_in, void* d_out, int out_size, void* d_ws, size_t ws_size, hipStream_t stream) {
    static int grid = 0;
    if (grid == 0) {
        if (n_in != 26 || out_size != (int)O_END || ws_size < WS_OPT_END) { fprintf(stderr, "kernel_launch: unexpected shapes (n_in %d out %d ws %zu need %zu); nothing launched\n", n_in, out_size, ws_size, (size_t)WS_OPT_END); grid = -1; return; }
        if (hipFuncSetAttribute((const void*)mega_fwd, hipFuncAttributeMaxDynamicSharedMemorySize, LDS_BYTES) != hipSuccess) { fprintf(stderr, "kernel_launch: hipFuncSetAttribute failed; nothing launched\n"); grid = -1; return; }
        int dev = 0, cus = 0, per_cu = 0;
        if (hipGetDevice(&dev) != hipSuccess || hipDeviceGetAttribute(&cus, hipDeviceAttributeMultiprocessorCount, dev) != hipSuccess) { grid = -1; return; }
        if (hipOccupancyMaxActiveBlocksPerMultiprocessor(&per_cu, (const void*)mega_fwd, NWAVES * 64, LDS_BYTES) != hipSuccess || per_cu < 1) { fprintf(stderr, "kernel_launch: occupancy query says %d workgroups per CU; nothing launched\n", per_cu); (void)hipGetLastError(); grid = -1; return; }
        grid = cus < 256 ? cus : 256;
    }
    if (grid < 0) return;
    (void)hipMemsetAsync((unsigned char*)d_ws + WS_CTL, 0, CTL_ZERO_BYTES, stream);
    Args a{}; for (int i = 0; i < 26; ++i) a.in[i] = d_in[i]; a.out = (float*)d_out; a.ws = (unsigned char*)d_ws; a.ph_lo = 0; a.ph_hi = N_PHASES;
    hipLaunchKernelGGL(mega_fwd, dim3(grid), dim3(NWAVES * 64), LDS_BYTES, stream, a);
}
```

```cpp
#include <hip/hip_runtime.h>
#include <cstdio>
#include <cstdint>
namespace pg8 {
#define PG8_LAS __attribute__((address_space(3)))
typedef unsigned short bf16_t;
typedef short bf16x8 __attribute__((ext_vector_type(8)));
typedef float f32x4 __attribute__((ext_vector_type(4)));
typedef unsigned u32x4 __attribute__((ext_vector_type(4)));
constexpr int BM = 256, BK = 64, HALF = 128, HTB = HALF * BK * 2  , STAGE_BYTES = 8 * HTB, NXCD = 8, WGM = 8;

__host__ __device__ __forceinline__ int lds_byte(int r, int c) { const int st = (r >> 4) * 2 + (c >> 5), rr = r & 15, cc = c & 31, ob = rr * 64 + cc * 2; return st * 1024 + (ob ^ (((ob >> 9) & 1) << 5)); }
__host__ __device__ __forceinline__ void stage_rc(int b, int& R, int& C) { const int st = b / 1024, sb = b % 1024, swz = sb ^ (((sb >> 9) & 1) << 5); R = (st >> 1) * 16 + swz / 64; C = (st & 1) * 32 + (swz % 64) / 2; }
__host__ __device__ __forceinline__ int perm32(int rho) { const int n = rho >> 4, i = rho & 15; return 8 * (i >> 2) + 4 * n + (i & 3); }

struct Unit { int pm, pn; };
struct Gemm { const bf16_t* A; const bf16_t* Bt; int M, N, K; };

struct StaticOrder {
    int nM, nN, nwg, G, c;
    __host__ __device__ void init(int M, int N, int G_, int c_) { nM = M / BM; nN = N / BM; nwg = nM * nN; G = G_; c = c_; }
    __host__ __device__ bool next(int i, Unit& u) const {
        const long L = (long)i * G + c; if (L >= nwg) return false;
        int wgid = (int)L; { const int q = nwg / NXCD, r = nwg % NXCD, xcd = wgid % NXCD, off = wgid / NXCD; wgid = (xcd < r ? xcd * (q + 1) : r * (q + 1) + (xcd - r) * q) + off; }
        const int nig = WGM * nN, gid = wgid / nig, fm = gid * WGM, gsz = (nM - fm) < WGM ? (nM - fm) : WGM;
        u.pm = fm + ((wgid % nig) % gsz); u.pn = (wgid % nig) / gsz; return true;
    }
    __device__ __forceinline__ void a_ready(const Unit&) const {}
    __device__ __forceinline__ void done(const Unit&) const {}
};

__device__ __forceinline__ unsigned cvt_pk_bf16(float lo, float hi) { unsigned r; asm volatile("v_cvt_pk_bf16_f32 %0, %1, %2" : "=v"(r) : "v"(lo), "v"(hi)); return r; }
typedef float f32x2 __attribute__((ext_vector_type(2)));
__device__ __forceinline__ f32x2 gelu_pk(f32x2 v) {
    const f32x2 av = __builtin_elementwise_abs(v), d = av * 0.2316418882f + 1.0f;
    f32x2 t; t.x = __builtin_amdgcn_rcpf(d.x); t.y = __builtin_amdgcn_rcpf(d.y);
    f32x2 q = t * 0.5307027145f + (-0.7265760135f); q = q * t + 0.7107068705f; q = q * t + (-0.142248368f); q = q * t + 0.127414796f; q = q * t;
    const f32x2 s = (v * v) * (-0.72134752044f);
    f32x2 e; e.x = __builtin_amdgcn_exp2f(s.x); e.y = __builtin_amdgcn_exp2f(s.y);
    const f32x2 m = v * (q * e), r = v - m;
    f32x2 o; o.x = v.x < 0.f ? m.x : r.x; o.y = v.y < 0.f ? m.y : r.y; return o;
}

typedef unsigned u32x2 __attribute__((ext_vector_type(2)));
constexpr int MPROMPT = 16384;
__device__ __forceinline__ float sigm(float x) { return __builtin_amdgcn_rcpf(1.0f + __builtin_amdgcn_exp2f(-1.4426950408889634f * x)); }
__device__ __forceinline__ float hsum4(f32x4 v) { return (v[0] + v[1]) + (v[2] + v[3]); }
__device__ __forceinline__ float hsq4(f32x4 v) { return (v[0] * v[0] + v[1] * v[1]) + (v[2] * v[2] + v[3] * v[3]); }
__device__ __forceinline__ void row_rstd(const float* ss, int row0, float (&rs)[2][4]) {
#pragma unroll
    for (int ai = 0; ai < 2; ++ai)
#pragma unroll
        for (int m = 0; m < 4; ++m) { const f32x4* p = (const f32x4*)(ss + (size_t)(row0 + ai * HALF + m * 16) * 16);
            const f32x4 a = p[0], b = p[1], c = p[2], d = p[3]; const float s = (hsum4(a) + hsum4(b)) + (hsum4(c) + hsum4(d));
            rs[ai][m] = 1.0f / sqrtf(s * (1.0f / 1024.0f) + 1e-6f); }
}
__device__ __forceinline__ u32x4 pack8(f32x4 v0, f32x4 v1) { u32x4 w; w.x = cvt_pk_bf16(v0[0], v0[1]); w.y = cvt_pk_bf16(v0[2], v0[3]); w.z = cvt_pk_bf16(v1[0], v1[1]); w.w = cvt_pk_bf16(v1[2], v1[3]); return w; }
__device__ __forceinline__ f32x4 bf4_lo(u32x4 w) { f32x4 r; r[0] = __uint_as_float(w.x << 16); r[1] = __uint_as_float(w.x & 0xffff0000u); r[2] = __uint_as_float(w.y << 16); r[3] = __uint_as_float(w.y & 0xffff0000u); return r; }
__device__ __forceinline__ f32x4 bf4_hi(u32x4 w) { f32x4 r; r[0] = __uint_as_float(w.z << 16); r[1] = __uint_as_float(w.z & 0xffff0000u); r[2] = __uint_as_float(w.w << 16); r[3] = __uint_as_float(w.w & 0xffff0000u); return r; }

struct EpiSwiglu {
    static constexpr bool PERM = true, AFTER_DRAIN = false;
    bf16_t* O; const float* ss;
    __device__ __forceinline__ void operator()(const f32x4 (&acc)[2][2][4][2], const Unit& u, int wr, int wc, int fr, int fq) const {
        const int row0 = u.pm * BM + wr * 64 + fr, col0 = u.pn * 128 + wc * 32 + 8 * fq;
        float rs[2][4]; row_rstd(ss, row0, rs);
#pragma unroll
        for (int ai = 0; ai < 2; ++ai)
#pragma unroll
            for (int m = 0; m < 4; ++m) { const float rr = rs[ai][m]; f32x4 o[2];
#pragma unroll
                for (int n = 0; n < 2; ++n) { const f32x4 g = acc[ai][0][m][n] * rr, up = acc[ai][1][m][n] * rr;
#pragma unroll
                    for (int e = 0; e < 4; ++e) o[n][e] = g[e] * sigm(g[e]) * up[e]; }
                *(u32x4*)(O + (size_t)(row0 + ai * HALF + m * 16) * 2816 + col0) = pack8(o[0], o[1]); }
    }
};
struct EpiRes {
    static constexpr bool PERM = true, AFTER_DRAIN = false;
    const float* base_lo; const float* base_hi; float* out; bf16_t* outb; float* ss; float scale;
    __device__ __forceinline__ void operator()(const f32x4 (&acc)[2][2][4][2], const Unit& u, int wr, int wc, int fr, int fq) const {
        const int row0 = u.pm * BM + wr * 64 + fr, col0 = u.pn * BM + wc * 32 + 8 * fq;
#pragma unroll
        for (int ai = 0; ai < 2; ++ai)
#pragma unroll
            for (int m = 0; m < 4; ++m) { const int r = row0 + ai * HALF + m * 16;
                const float* bp = (u.pm < 64) ? base_lo + (size_t)r * 1024 : base_hi + (size_t)(r - MPROMPT) * 1024; float q = 0.f;
#pragma unroll
                for (int bj = 0; bj < 2; ++bj) { const int c = col0 + bj * HALF;
                    const f32x4 v0 = *(const f32x4*)(bp + c) + acc[ai][bj][m][0] * scale, v1 = *(const f32x4*)(bp + c + 4) + acc[ai][bj][m][1] * scale;
                    *(f32x4*)(out + (size_t)r * 1024 + c) = v0; *(f32x4*)(out + (size_t)r * 1024 + c + 4) = v1;
                    if (outb) *(u32x4*)(outb + (size_t)r * 1024 + c) = pack8(v0, v1);
                    q += hsq4(v0) + hsq4(v1); }
                q += __shfl_xor(q, 16); q += __shfl_xor(q, 32);
                if (fq == 0) ss[(size_t)r * 16 + u.pn * 4 + wc] = q; }
    }
};
struct EpiInProj {
    static constexpr bool PERM = true, AFTER_DRAIN = false;
    const float* ss; bf16_t *QB, *KB, *VB, *UG, *GA, *GB; float* VG; float* VGS; float* out; float qscale;
    __device__ __forceinline__ void operator()(const f32x4 (&acc)[2][2][4][2], const Unit& u, int wr, int wc, int fr, int fq) const {
        const int row0 = u.pm * BM + wr * 64 + fr, cw = wc * 32 + 8 * fq;
        float rs[2][4]; row_rstd(ss, row0, rs);
        const int pn = u.pn;
        if (pn < 2) {
#pragma unroll
            for (int ai = 0; ai < 2; ++ai)
#pragma unroll
                for (int m = 0; m < 4; ++m) { const float rr = rs[ai][m] * qscale; bf16_t* p = QB + (size_t)(row0 + ai * HALF + m * 16) * 512 + pn * 256 + cw;
#pragma unroll
                    for (int bj = 0; bj < 2; ++bj) *(u32x4*)(p + bj * HALF) = pack8(acc[ai][bj][m][0] * rr, acc[ai][bj][m][1] * rr); }
        } else if (pn < 6) {
            const bool isv = pn >= 4; const int ct = (isv ? pn - 4 : pn - 2) * 256 + cw; bf16_t* B = isv ? VB : KB;
            float* ob = out + (u.pm < 64 ? (isv ? 25427968 : 17039360) : (isv ? 34209792 : 34078720));
#pragma unroll
            for (int ai = 0; ai < 2; ++ai)
#pragma unroll
                for (int m = 0; m < 4; ++m) { const int r = row0 + ai * HALF + m * 16; const float rr = rs[ai][m];
                    float* po = ob + (size_t)(u.pm < 64 ? r : r - MPROMPT) * 512 + ct; bf16_t* pb = B + (size_t)r * 512 + ct;
#pragma unroll
                    for (int bj = 0; bj < 2; ++bj) { const f32x4 v0 = acc[ai][bj][m][0] * rr, v1 = acc[ai][bj][m][1] * rr;
                        *(f32x4*)(po + bj * HALF) = v0; *(f32x4*)(po + bj * HALF + 4) = v1; *(u32x4*)(pb + bj * HALF) = pack8(v0, v1); } }
        } else if (pn < 8) {
#pragma unroll
            for (int ai = 0; ai < 2; ++ai)
#pragma unroll
                for (int m = 0; m < 4; ++m) { const float rr = rs[ai][m]; bf16_t* p = UG + (size_t)(row0 + ai * HALF + m * 16) * 512 + (pn - 6) * 256 + cw;
#pragma unroll
                    for (int bj = 0; bj < 2; ++bj) { const f32x4 v0 = acc[ai][bj][m][0] * rr, v1 = acc[ai][bj][m][1] * rr;
                        const f32x2 a = gelu_pk((f32x2){v0[0], v0[1]}), b = gelu_pk((f32x2){v0[2], v0[3]}), c = gelu_pk((f32x2){v1[0], v1[1]}), d = gelu_pk((f32x2){v1[2], v1[3]});
                        *(u32x4*)(p + bj * HALF) = pack8((f32x4){a.x, a.y, b.x, b.y}, (f32x4){c.x, c.y, d.x, d.y}); } }
        } else if (pn < 10) {
#pragma unroll
            for (int ai = 0; ai < 2; ++ai)
#pragma unroll
                for (int m = 0; m < 4; ++m) { const int r = row0 + ai * HALF + m * 16; const float rr = rs[ai][m]; float* p = VG + (size_t)r * 512 + (pn - 8) * 256 + cw; float s1 = 0.f, s2 = 0.f;
#pragma unroll
                    for (int bj = 0; bj < 2; ++bj) { const f32x4 v0 = acc[ai][bj][m][0] * rr, v1 = acc[ai][bj][m][1] * rr;
                        const f32x2 a = gelu_pk((f32x2){v0[0], v0[1]}), b = gelu_pk((f32x2){v0[2], v0[3]}), c = gelu_pk((f32x2){v1[0], v1[1]}), d = gelu_pk((f32x2){v1[2], v1[3]});
                        const f32x4 g0 = (f32x4){a.x, a.y, b.x, b.y}, g1 = (f32x4){c.x, c.y, d.x, d.y};
                        *(f32x4*)(p + bj * HALF) = g0; *(f32x4*)(p + bj * HALF + 4) = g1; s1 += hsum4(g0) + hsum4(g1); s2 += hsq4(g0) + hsq4(g1); }
                    s1 += __shfl_xor(s1, 16); s1 += __shfl_xor(s1, 32); s2 += __shfl_xor(s2, 16); s2 += __shfl_xor(s2, 32);
                    if (fq == 0) { float* q = VGS + (size_t)r * 16 + ((pn - 8) * 4 + wc) * 2; q[0] = s1; q[1] = s2; } }
        } else {
            const bool isb = pn >= 14; bf16_t* B = isb ? GB : GA; const int ct = (isb ? pn - 14 : pn - 10) * 256 + cw;
#pragma unroll
            for (int ai = 0; ai < 2; ++ai)
#pragma unroll
                for (int m = 0; m < 4; ++m) { const float rr = rs[ai][m]; bf16_t* p = B + (size_t)(row0 + ai * HALF + m * 16) * 1024 + ct;
#pragma unroll
                    for (int bj = 0; bj < 2; ++bj) { f32x4 v0 = acc[ai][bj][m][0] * rr, v1 = acc[ai][bj][m][1] * rr;
#pragma unroll
                        for (int e = 0; e < 4; ++e) { v0[e] = sigm(v0[e]); v1[e] = sigm(v1[e]); }
                        *(u32x4*)(p + bj * HALF) = pack8(v0, v1); } }
        }
    }
};
struct EpiGate1 {
    static constexpr bool PERM = true, AFTER_DRAIN = false;
    const bf16_t* G; float* T;
    __device__ __forceinline__ void operator()(const f32x4 (&acc)[2][2][4][2], const Unit& u, int wr, int wc, int fr, int fq) const {
        const int row0 = u.pm * BM + wr * 64 + fr, col0 = u.pn * BM + wc * 32 + 8 * fq;
#pragma unroll
        for (int ai = 0; ai < 2; ++ai)
#pragma unroll
            for (int m = 0; m < 4; ++m) { const size_t off = (size_t)(row0 + ai * HALF + m * 16) * 1024 + col0;
#pragma unroll
                for (int bj = 0; bj < 2; ++bj) { const u32x4 gw = *(const u32x4*)(G + off + bj * HALF);
                    *(f32x4*)(T + off + bj * HALF) = bf4_lo(gw) * acc[ai][bj][m][0]; *(f32x4*)(T + off + bj * HALF + 4) = bf4_hi(gw) * acc[ai][bj][m][1]; } }
    }
};
struct EpiGate2 {
    static constexpr bool PERM = true, AFTER_DRAIN = false;
    const bf16_t* G; const float* T; bf16_t* O;
    __device__ __forceinline__ void operator()(const f32x4 (&acc)[2][2][4][2], const Unit& u, int wr, int wc, int fr, int fq) const {
        const int row0 = u.pm * BM + wr * 64 + fr, col0 = u.pn * BM + wc * 32 + 8 * fq;
#pragma unroll
        for (int ai = 0; ai < 2; ++ai)
#pragma unroll
            for (int m = 0; m < 4; ++m) { const size_t off = (size_t)(row0 + ai * HALF + m * 16) * 1024 + col0;
#pragma unroll
                for (int bj = 0; bj < 2; ++bj) { const u32x4 gw = *(const u32x4*)(G + off + bj * HALF);
                    const f32x4 v0 = *(const f32x4*)(T + off + bj * HALF) + bf4_lo(gw) * acc[ai][bj][m][0], v1 = *(const f32x4*)(T + off + bj * HALF + 4) + bf4_hi(gw) * acc[ai][bj][m][1];
                    *(u32x4*)(O + off + bj * HALF) = pack8(v0, v1); } }
    }
};

template <class Epi, class Sched, bool ALIGN_EPI = false, bool SP2 = false>
__device__ __forceinline__ void gemm_phase(PG8_LAS unsigned char* lds, const Gemm g, const Sched& S, const Epi& E) {
    const int tid = threadIdx.x, wid = __builtin_amdgcn_readfirstlane(tid >> 6), lane = tid & 63, wr = wid >> 2, wc = wid & 3, fr = lane & 15, fq = lane >> 4;
    const int K = g.K, nt = K / BK;
    unsigned voffA[2], voffB[2];
#pragma unroll
    for (int i = 0; i < 2; ++i) { int R, C; stage_rc(tid * 16 + i * 8192, R, C); const int Rb = Epi::PERM ? ((R & ~31) + perm32(R & 31)) : R;
        voffA[i] = (unsigned)(R * K + C) * 2u; voffB[i] = (unsigned)(Rb * K + C) * 2u; }
    const size_t kstep = (size_t)(BK * 2);
    const size_t hstep = (size_t)HALF * K * 2;
    const size_t tstep = 2 * hstep;
    const unsigned ldsw = (unsigned)wid * 1024u;
    const int aoff = lds_byte(wr * 64 + fr, fq * 8), boff = lds_byte(wc * 32 + fr, fq * 8);
#define PG8_SA(b, h) (((b) * 2 + (h)) * HTB)
#define PG8_SB(b, h) ((4 + (b) * 2 + (h)) * HTB)
#define PG8_STAGE(bufoff, gbase, voff) do { _Pragma("unroll") for (int _i = 0; _i < 2; ++_i) \
        __builtin_amdgcn_global_load_lds((const unsigned*)((const char*)(gbase) + (voff)[_i]), (PG8_LAS unsigned*)(lds + (bufoff) + ldsw + _i * 8192), 16, 0, 0); } while (0)
#define PG8_LDA(dst, b, h) do { _Pragma("unroll") for (int m = 0; m < 4; ++m) _Pragma("unroll") for (int k = 0; k < 2; ++k) dst[m][k] = *(const PG8_LAS bf16x8*)(lds + PG8_SA(b, h) + aoff + m * 2048 + k * 1024); } while (0)
#define PG8_LDB(dst, b, h) do { _Pragma("unroll") for (int n = 0; n < 2; ++n) _Pragma("unroll") for (int k = 0; k < 2; ++k) dst[n][k] = *(const PG8_LAS bf16x8*)(lds + PG8_SB(b, h) + boff + n * 2048 + k * 1024); } while (0)
#define PG8_MMA(ai, bj, At, Bt) do { __builtin_amdgcn_s_setprio(1); _Pragma("unroll") for (int m = 0; m < 4; ++m) _Pragma("unroll") for (int n = 0; n < 2; ++n) _Pragma("unroll") for (int k = 0; k < 2; ++k) \
        acc[ai][bj][m][n] = __builtin_amdgcn_mfma_f32_16x16x32_bf16(Bt[n][k], At[m][k], acc[ai][bj][m][n], 0, 0, 0); __builtin_amdgcn_s_setprio(0); } while (0)
#define PG8_WAIT_V(n) asm volatile("s_waitcnt vmcnt(" #n ")" ::: "memory")
#define PG8_WAIT_L(n) asm volatile("s_waitcnt lgkmcnt(" #n ")" ::: "memory")
#define PG8_BAR __builtin_amdgcn_s_barrier()
#define PG8_SCHED __builtin_amdgcn_sched_barrier(0)
    Unit cur, nxt; int ui = 0;
    if (!S.next(0, cur)) return;
    f32x4 acc[2][2][4][2];
#pragma unroll
    for (int a = 0; a < 2; ++a)
#pragma unroll
        for (int b = 0; b < 2; ++b)
#pragma unroll
            for (int m = 0; m < 4; ++m)
#pragma unroll
                for (int n = 0; n < 2; ++n) acc[a][b][m][n] = (f32x4){0.f, 0.f, 0.f, 0.f};
    bf16x8 At[4][2], B0[2][2], B1[2][2];
    const char* cA = (const char*)g.A + (size_t)cur.pm * tstep; const char* cB = (const char*)g.Bt + (size_t)cur.pn * tstep;
    S.a_ready(cur);
    if constexpr (SP2) {
        PG8_STAGE(PG8_SB(0, 0), cB, voffB); PG8_STAGE(PG8_SB(0, 1), cB + hstep, voffB); PG8_STAGE(PG8_SA(0, 0), cA, voffA); PG8_STAGE(PG8_SA(0, 1), cA + hstep, voffA);
        if (wr == 1) PG8_BAR;
        PG8_WAIT_V(2); PG8_BAR;
        PG8_STAGE(PG8_SB(1, 0), cB + kstep, voffB); PG8_STAGE(PG8_SA(1, 0), cA + kstep, voffA); PG8_STAGE(PG8_SB(1, 1), cB + hstep + kstep, voffB);
        PG8_WAIT_V(6); PG8_BAR;
    } else {
        PG8_STAGE(PG8_SB(0, 0), cB, voffB); PG8_STAGE(PG8_SA(0, 0), cA, voffA); PG8_STAGE(PG8_SB(0, 1), cB + hstep, voffB); PG8_STAGE(PG8_SA(0, 1), cA + hstep, voffA);
        if (wr == 1) PG8_BAR;
        PG8_WAIT_V(4); PG8_BAR;
        PG8_STAGE(PG8_SB(1, 0), cB + kstep, voffB); PG8_STAGE(PG8_SA(1, 0), cA + kstep, voffA); PG8_STAGE(PG8_SB(1, 1), cB + hstep + kstep, voffB);
        PG8_WAIT_V(6); PG8_BAR;
    }
    for (;;) {
        const bool has_next = S.next(ui + 1, nxt);
        const char* nA = has_next ? (const char*)g.A + (size_t)nxt.pm * tstep : cA; const char* nB = has_next ? (const char*)g.Bt + (size_t)nxt.pn * tstep : cB;
        for (int t = 0; t < nt; t += 2) {
            const bool last = (t == nt - 2);
            const char* a1 = cA + (size_t)(t + 1) * kstep;
            const char* a2 = last ? nA : cA + (size_t)(t + 2) * kstep; const char* b2 = last ? nB : cB + (size_t)(t + 2) * kstep;
            const char* a3 = a2 + kstep; const char* b3 = b2 + kstep;
            if (last && has_next) S.a_ready(nxt);
            if constexpr (SP2) {
            PG8_LDB(B0, 0, 0); PG8_LDB(B1, 0, 1); PG8_SCHED; PG8_LDA(At, 0, 0); PG8_STAGE(PG8_SA(1, 1), a1 + hstep, voffA);
            PG8_WAIT_V(8); PG8_WAIT_L(0); PG8_BAR; PG8_MMA(0, 0, At, B0); PG8_MMA(0, 1, At, B1); PG8_BAR; PG8_SCHED;
            PG8_LDA(At, 0, 1); PG8_STAGE(PG8_SB(0, 0), b2, voffB); PG8_STAGE(PG8_SB(0, 1), b2 + hstep, voffB); PG8_STAGE(PG8_SA(0, 0), a2, voffA);
            PG8_WAIT_V(8); PG8_WAIT_L(0); PG8_BAR; PG8_MMA(1, 0, At, B0); PG8_MMA(1, 1, At, B1); PG8_BAR; PG8_SCHED;
            PG8_LDB(B0, 1, 0); PG8_LDB(B1, 1, 1); PG8_SCHED; PG8_LDA(At, 1, 0); PG8_STAGE(PG8_SA(0, 1), a2 + hstep, voffA);
            PG8_WAIT_V(8); PG8_WAIT_L(0); PG8_BAR; PG8_MMA(0, 0, At, B0); PG8_MMA(0, 1, At, B1); PG8_BAR; PG8_SCHED;
            PG8_LDA(At, 1, 1); PG8_STAGE(PG8_SB(1, 0), b3, voffB); PG8_STAGE(PG8_SB(1, 1), b3 + hstep, voffB); PG8_STAGE(PG8_SA(1, 0), a3, voffA);
            PG8_WAIT_V(8); PG8_WAIT_L(0); PG8_BAR; PG8_MMA(1, 0, At, B0); PG8_MMA(1, 1, At, B1); PG8_BAR; PG8_SCHED;
            } else {
            PG8_LDB(B0, 0, 0); PG8_SCHED; PG8_LDA(At, 0, 0); PG8_STAGE(PG8_SA(1, 1), a1 + hstep, voffA);
            PG8_WAIT_L(8); PG8_BAR; PG8_WAIT_L(0); PG8_MMA(0, 0, At, B0); PG8_BAR; PG8_SCHED;
            PG8_LDB(B1, 0, 1); PG8_STAGE(PG8_SB(0, 0), b2, voffB);
            PG8_BAR; PG8_WAIT_L(0); PG8_MMA(0, 1, At, B1); PG8_BAR;
            PG8_LDA(At, 0, 1); PG8_STAGE(PG8_SA(0, 0), a2, voffA);
            PG8_BAR; PG8_WAIT_L(0); PG8_MMA(1, 0, At, B0); PG8_BAR; PG8_SCHED;
            PG8_STAGE(PG8_SB(0, 1), b2 + hstep, voffB);
            PG8_WAIT_V(6); PG8_BAR; PG8_MMA(1, 1, At, B1); PG8_BAR;
            PG8_LDB(B0, 1, 0); PG8_SCHED; PG8_LDA(At, 1, 0); PG8_STAGE(PG8_SA(0, 1), a2 + hstep, voffA);
            PG8_WAIT_L(8); PG8_BAR; PG8_WAIT_L(0); PG8_MMA(0, 0, At, B0); PG8_BAR; PG8_SCHED;
            PG8_LDB(B1, 1, 1); PG8_STAGE(PG8_SB(1, 0), b3, voffB);
            PG8_BAR; PG8_WAIT_L(0); PG8_MMA(0, 1, At, B1); PG8_BAR;
            PG8_LDA(At, 1, 1); PG8_STAGE(PG8_SA(1, 0), a3, voffA);
            PG8_BAR; PG8_WAIT_L(0); PG8_MMA(1, 0, At, B0); PG8_BAR; PG8_SCHED;
            PG8_STAGE(PG8_SB(1, 1), b3 + hstep, voffB);
            PG8_WAIT_V(6); PG8_BAR; PG8_MMA(1, 1, At, B1); PG8_BAR;
            }
        }
        if constexpr (ALIGN_EPI) { if (wr == 0) PG8_BAR; }
        if constexpr (!Epi::AFTER_DRAIN) { E(acc, cur, wr, wc, fr, fq); S.done(cur); }
        if (!has_next) break;
#pragma unroll
        for (int a = 0; a < 2; ++a)
#pragma unroll
            for (int b = 0; b < 2; ++b)
#pragma unroll
                for (int m = 0; m < 4; ++m)
#pragma unroll
                    for (int n = 0; n < 2; ++n) acc[a][b][m][n] = (f32x4){0.f, 0.f, 0.f, 0.f};
        cur = nxt; cA = nA; cB = nB; ++ui;
        if constexpr (ALIGN_EPI) { if (wr == 1) PG8_BAR; }
    }
    PG8_WAIT_V(0);
    if constexpr (!ALIGN_EPI) { if (wr == 0) PG8_BAR; }
    PG8_BAR;
    if constexpr (Epi::AFTER_DRAIN) { E.fused(acc, cur, wr, wc, fr, fq, lds, wid, lane); S.done(cur); }
#undef PG8_SA
#undef PG8_SB
#undef PG8_STAGE
#undef PG8_LDA
#undef PG8_LDB
#undef PG8_MMA
#undef PG8_WAIT_V
#undef PG8_WAIT_L
#undef PG8_BAR
#undef PG8_SCHED
}
}
#include <hip/hip_bf16.h>
#include <cmath>
namespace attn_body {
using bf16=__hip_bfloat16;
using bf16x8=__attribute__((ext_vector_type(8)))short;
using s16x4=__attribute__((ext_vector_type(4)))short;
using f32x16=__attribute__((ext_vector_type(16)))float;
using u32x4=__attribute__((ext_vector_type(4)))unsigned;
constexpr int SEQ=4096,D=64,KP=512,OP=1024;
constexpr int NW=8,QBLK=32,QB=QBLK*NW,KVBLK=64,NQB=SEQ/QB;
__device__ __forceinline__ int crow(int r,int hi){return (r&3)+8*(r>>2)+4*hi;}
#define SBAR() __builtin_amdgcn_sched_barrier(0)
__device__ __forceinline__ void cmask(f32x16&p0,f32x16&p1,int jb,int qrel,int hi){
  const float NEG=-INFINITY; int kb=64*jb+4*hi;
  #pragma unroll
  for(int r=0;r<16;++r){int kv=kb+(r&3)+8*(r>>2); if(kv>qrel)p0[r]=NEG; if(kv+32>qrel)p1[r]=NEG;}
}

constexpr int NSLOT=3, SLOTB=8192;
constexpr int LDS_K=0, LDS_V=NSLOT*SLOTB, LDS_WS=2*NSLOT*SLOTB, LDS_OST=LDS_WS+NW*64*4, LDS_BYTES=LDS_OST+NW*4096;
constexpr float C2=0.125f*1.4426950408889634f;
__device__ __forceinline__ void glds16(const void*gsrc,unsigned lds_dst){unsigned keep;
  asm volatile("s_mov_b32 %0, m0\n\ts_mov_b32 m0, %2\n\ts_nop 0\n\tglobal_load_lds_dwordx4 %1, off\n\ts_mov_b32 m0, %0":"=&s"(keep):"v"(gsrc),"s"(lds_dst):"memory");}
__device__ __forceinline__ float max3f(float a,float b,float c){float r;asm("v_max3_f32 %0, %1, %2, %3":"=v"(r):"v"(a),"v"(b),"v"(c));return r;}
__device__ __forceinline__ float max2f(float a,float b){float r;asm("v_max_f32_e32 %0, %1, %2":"=v"(r):"v"(a),"v"(b));return r;}
__device__ __forceinline__ float fadd_s(float a,float b){float r;asm("v_add_f32_e32 %0, %1, %2":"=v"(r):"v"(a),"v"(b));return r;}
__device__ __forceinline__ float fsub_s(float a,float b){float r;asm("v_sub_f32_e32 %0, %1, %2":"=v"(r):"v"(a),"v"(b));return r;}
typedef float f32x2_t __attribute__((ext_vector_type(2))); typedef __bf16 bf16x2_t __attribute__((ext_vector_type(2)));
__device__ __forceinline__ unsigned cvtpk_s(float lo,float hi){f32x2_t v={lo,hi};bf16x2_t b=__builtin_convertvector(v,bf16x2_t);return __builtin_bit_cast(unsigned,b);}
#define WAIT_BAR(N) asm volatile("s_waitcnt vmcnt(" #N ") lgkmcnt(0)\n\ts_barrier":::"memory")

__device__ __forceinline__ void qkt(f32x16&p0,f32x16&p1,const char*Kslot,const bf16x8*qr,const f32x16&negm,int r32,int hi){
  const char*kb=Kslot+hi*1024+r32*16;
  #pragma unroll
  for(int d0=0;d0<4;++d0){
    const bf16x8 b0=*reinterpret_cast<const bf16x8*>(kb+d0*2048);
    const bf16x8 b1=*reinterpret_cast<const bf16x8*>(kb+d0*2048+512);
    if(d0==0){p0=__builtin_amdgcn_mfma_f32_32x32x16_bf16(b0,qr[0],negm,0,0,0);p1=__builtin_amdgcn_mfma_f32_32x32x16_bf16(b1,qr[0],negm,0,0,0);}
    else{p0=__builtin_amdgcn_mfma_f32_32x32x16_bf16(b0,qr[d0],p0,0,0,0);p1=__builtin_amdgcn_mfma_f32_32x32x16_bf16(b1,qr[d0],p1,0,0,0);}}
}
typedef __attribute__((address_space(3))) const char* lds_cptr;
typedef short v4i16_t __attribute__((ext_vector_type(4)));
__device__ __forceinline__ void kload8(bf16x8*kf,lds_cptr kp){
  kf[0]=*(const __attribute__((address_space(3))) bf16x8*)(kp);      kf[1]=*(const __attribute__((address_space(3))) bf16x8*)(kp+512);
  kf[2]=*(const __attribute__((address_space(3))) bf16x8*)(kp+2048); kf[3]=*(const __attribute__((address_space(3))) bf16x8*)(kp+2560);
  kf[4]=*(const __attribute__((address_space(3))) bf16x8*)(kp+4096); kf[5]=*(const __attribute__((address_space(3))) bf16x8*)(kp+4608);
  kf[6]=*(const __attribute__((address_space(3))) bf16x8*)(kp+6144); kf[7]=*(const __attribute__((address_space(3))) bf16x8*)(kp+6656);
}
__device__ __forceinline__ void kload2(bf16x8*kf,lds_cptr kp,int j){ kf[2*j]=*(const __attribute__((address_space(3))) bf16x8*)(kp+j*2048); kf[2*j+1]=*(const __attribute__((address_space(3))) bf16x8*)(kp+j*2048+512); }
__device__ __forceinline__ s16x4 vtr(lds_cptr p){ return __builtin_bit_cast(s16x4,__builtin_amdgcn_ds_read_tr16_b64_v4i16((__attribute__((address_space(3))) v4i16_t*)p)); }
__device__ __forceinline__ float rowmax(const f32x16&p0,const f32x16&p1){
  float a=max3f(p0[0],p0[1],p1[0]),b=max3f(p0[2],p0[3],p1[1]);a=max3f(a,p1[2],p1[3]);
  #pragma unroll
  for(int r=4;r<16;r+=4){a=max3f(a,p0[r],p0[r+1]);b=max3f(b,p0[r+2],p0[r+3]);a=max3f(a,p1[r],p1[r+1]);b=max3f(b,p1[r+2],p1[r+3]);}
  const float m=max2f(a,b);
  auto rr=__builtin_amdgcn_permlane32_swap(__float_as_uint(m),__float_as_uint(m),false,false);
  return max2f(__uint_as_float(rr[0]),__uint_as_float(rr[1]));
}
__device__ __forceinline__ void pv(f32x16*o,int vb,bf16x8 pa0,bf16x8 pa1,bf16x8 pa2,bf16x8 pa3){
  #pragma unroll
  for(int d0=0;d0<2;++d0){s16x4 lo[4],hi[4];
    #pragma unroll
    for(int ks=0;ks<4;++ks){
      asm volatile("ds_read_b64_tr_b16 %0,%1 offset:%c2":"=&v"(lo[ks]):"v"(vb),"i"(d0*4096+ks*1024):"memory");
      asm volatile("ds_read_b64_tr_b16 %0,%1 offset:%c2":"=&v"(hi[ks]):"v"(vb),"i"(d0*4096+ks*1024+512):"memory");}
    asm volatile("s_waitcnt lgkmcnt(0)":::"memory");SBAR();
    #define PK(k) (bf16x8){lo[k][0],lo[k][1],lo[k][2],lo[k][3],hi[k][0],hi[k][1],hi[k][2],hi[k][3]}
    o[d0]=__builtin_amdgcn_mfma_f32_32x32x16_bf16(pa0,PK(0),o[d0],0,0,0);
    o[d0]=__builtin_amdgcn_mfma_f32_32x32x16_bf16(pa1,PK(1),o[d0],0,0,0);
    o[d0]=__builtin_amdgcn_mfma_f32_32x32x16_bf16(pa2,PK(2),o[d0],0,0,0);
    o[d0]=__builtin_amdgcn_mfma_f32_32x32x16_bf16(pa3,PK(3),o[d0],0,0,0);
    #undef PK
  }
}

#ifndef ATTN_STORE16
#define ATTN_STORE16(p,v) (*(u32x4*)(p)=(v))
#endif
template<int THRL> __device__ __forceinline__ void attn_unit(int b,int qcol,int kcol,int vcol,int ocol,int qb,const bf16*Q,const bf16*__restrict__ K,const bf16*__restrict__ V,bf16*O,char*shm){
  const int tid=threadIdx.x,lane=tid&63,r32=lane&31,hi=lane>>5; const int wid=__builtin_amdgcn_readfirstlane(tid>>6);
  const long rowbase=(long)b*SEQ; const int q0=qb*QB;
  const bf16*Qw=Q+(rowbase+q0+wid*QBLK)*KP+qcol;
  const bf16*Kh=K+rowbase*KP+kcol,*Vh=V+rowbase*KP+vcol;
  const unsigned lds0=(unsigned)(uintptr_t)shm;
  float*wsf=(float*)(shm+LDS_WS)+wid*64;
  const bf16*ksrc=Kh+(long)lane*KP+wid*8;
  const bf16*vsrc=Vh+(long)(16*(wid&3)+(lane>>2))*KP+(wid>>2)*32+(lane&3)*8;
  const unsigned kdst=lds0+LDS_K+wid*1024, vdst=lds0+LDS_V+wid*1024;
  #define DMA_K(t,slot) glds16(ksrc+(long)(t)*KVBLK*KP,(unsigned)__builtin_amdgcn_readfirstlane(kdst+(slot)))
  #define DMA_V(t,slot) glds16(vsrc+(long)(t)*KVBLK*KP,(unsigned)__builtin_amdgcn_readfirstlane(vdst+(slot)))
  const int vb0=(int)(lds0+LDS_V)+((lane>>4)&1)*32+(lane&3)*8+(4*hi+((lane&15)>>2))*64;
  const char*Kbase=shm+LDS_K; bf16x8 kf[8];
  const lds_cptr shm3=(lds_cptr)shm; const lds_cptr kp0=shm3+LDS_K+hi*1024+r32*16; const lds_cptr vp0=shm3+LDS_V+((lane>>4)&1)*32+(lane&3)*8+(4*hi+((lane&15)>>2))*64;
  const int NT=(q0+QB)/KVBLK;
  DMA_K(0,0);DMA_V(0,0);DMA_K(1,SLOTB);
  bf16x8 qr[4];
  #pragma unroll
  for(int d0=0;d0<4;++d0)qr[d0]=*reinterpret_cast<const bf16x8*>(&Qw[(long)r32*KP+d0*16+hi*8]);
  float mhat=0.f,l_reg=0.f;f32x16 o[2];o[0]=f32x16{};o[1]=f32x16{};f32x16 negm=f32x16{};asm volatile("":"+v"(negm));
  const int qrel=wid*QBLK+r32;
  #define CMASK(P0,P1,t) do{int jb_=(t)-(NT-4); if(jb_>=0)cmask(P0,P1,jb_,qrel,hi);}while(0)
  bool resc=false;
  #define START(P0,P1) do{ const float rm=rowmax(P0,P1); resc=false; \
    { const float dl=rm; mhat=fadd_s(mhat,dl); \
      _Pragma("unroll") for(int r=0;r<16;++r){P0[r]=fsub_s(P0[r],dl);P1[r]=fsub_s(P1[r],dl);} \
      _Pragma("unroll") for(int r=0;r<16;++r)negm[r]=-mhat; asm volatile("":"+v"(negm)); } \
    _Pragma("unroll") for(int r=0;r<16;++r)P0[r]=__builtin_amdgcn_exp2f(P0[r]); }while(0)
  #define RESC() do{ if(resc){ asm volatile("s_waitcnt lgkmcnt(0)":::"memory"); \
      _Pragma("unroll") for(int d_=0;d_<2;++d_) _Pragma("unroll") for(int r=0;r<16;++r)o[d_][r]*=wsf[crow(r,hi)]; } }while(0)
  f32x16 pA0,pA1,pB0,pB1;
  int sl_prev=0,sl_cur=0,sl_next=SLOTB;
  #define ROT() do{sl_prev=sl_cur;sl_cur=sl_next;sl_next=(sl_next==(NSLOT-1)*SLOTB)?0:sl_next+SLOTB;}while(0)
  DMA_K(2,2*SLOTB);
  WAIT_BAR(3);
  qkt(pA0,pA1,Kbase,qr,negm,r32,hi);asm volatile("s_nop 15\n\ts_nop 7":"+v"(pA0),"+v"(pA1));CMASK(pA0,pA1,0);
  START(pA0,pA1);
  _Pragma("unroll") for(int r=0;r<16;++r)pA1[r]=__builtin_amdgcn_exp2f(pA1[r]);
  WAIT_BAR(0);
  DMA_K(3,0);DMA_V(1,SLOTB);
  ROT();
  kload8(kf,kp0+sl_cur);
  WAIT_BAR(2);
  s16x4 vlo[8],vhi[8]; u32x4 pw0,pw1,pw2,pw3;
  #define PKW(P,B) cvtpk_s(P[B],P[B+1])
  #define PAF(k) __builtin_bit_cast(bf16x8,pw##k)
  #define VFR(i) (bf16x8){vlo[i][0],vlo[i][1],vlo[i][2],vlo[i][3],vhi[i][0],vhi[i][1],vhi[i][2],vhi[i][3]}
  #define PIN(x) asm volatile("":"+v"(x))
  #define MX3(a,b,c) __builtin_fmaxf(__builtin_fmaxf((a),(b)),(c))
  #define GAPA(MF,A0,A1,A2,A3,W0,W1,PW) do{ MF; sacc+=A0; sacc+=A1; sacc+=A2; sacc+=A3; PIN(sacc); W0; W1; PIN(PW); SBAR(); }while(0)
  #define EX(v) __builtin_amdgcn_exp2f(v)
  #define GAPB(MF,X,B) do{ MF; X[B]=EX(X[B]); X[B+1]=EX(X[B+1]); X[B+2]=EX(X[B+2]); X[B+3]=EX(X[B+3]); PIN(X); SBAR(); }while(0)
  #define VRD(i) do{ vlo[i]=vtr(vp_+(((i)>>2)*4096+((i)&3)*1024)); vhi[i]=vtr(vp_+(((i)>>2)*4096+((i)&3)*1024+512)); }while(0)
  #define KRD(G,j) do{ if(G){ kload2(kf,kp0+sl_next,j); SBAR(); } }while(0)
  #define STEP(C0,C1,P0,P1,t,GK,GV,GL) do{ SBAR(); \
    const lds_cptr vp_=vp0+sl_prev; \
    VRD(0); SBAR(); float sacc=(P0[0]+P0[1]); \
    GAPA(C0=__builtin_amdgcn_mfma_f32_32x32x16_bf16(kf[0],qr[0],negm,0,0,0), P0[2],P0[3],P0[4],P0[5],     pw0[0]=PKW(P0,0), pw0[1]=PKW(P0,2), pw0); \
    VRD(4); SBAR(); GAPA(C1=__builtin_amdgcn_mfma_f32_32x32x16_bf16(kf[1],qr[0],negm,0,0,0), P0[6],P0[7],P0[8],P0[9],     pw0[2]=PKW(P0,4), pw0[3]=PKW(P0,6), pw0); \
    VRD(1); SBAR(); GAPA(C0=__builtin_amdgcn_mfma_f32_32x32x16_bf16(kf[2],qr[1],C0,0,0,0),   P0[10],P0[11],P0[12],P0[13], pw1[0]=PKW(P0,8), pw1[1]=PKW(P0,10), pw1); \
    VRD(5); SBAR(); GAPA(C1=__builtin_amdgcn_mfma_f32_32x32x16_bf16(kf[3],qr[1],C1,0,0,0),   P0[14],P0[15],P1[0],P1[1],   pw1[2]=PKW(P0,12),pw1[3]=PKW(P0,14), pw1); \
    VRD(2); SBAR(); GAPA(C0=__builtin_amdgcn_mfma_f32_32x32x16_bf16(kf[4],qr[2],C0,0,0,0),   P1[2],P1[3],P1[4],P1[5],     pw2[0]=PKW(P1,0), pw2[1]=PKW(P1,2), pw2); \
    VRD(6); SBAR(); GAPA(C1=__builtin_amdgcn_mfma_f32_32x32x16_bf16(kf[5],qr[2],C1,0,0,0),   P1[6],P1[7],P1[8],P1[9],     pw2[2]=PKW(P1,4), pw2[3]=PKW(P1,6), pw2); \
    VRD(3); SBAR(); GAPA(C0=__builtin_amdgcn_mfma_f32_32x32x16_bf16(kf[6],qr[3],C0,0,0,0),   P1[10],P1[11],P1[12],P1[13], pw3[0]=PKW(P1,8), pw3[1]=PKW(P1,10), pw3); \
    VRD(7); SBAR(); GAPA(C1=__builtin_amdgcn_mfma_f32_32x32x16_bf16(kf[7],qr[3],C1,0,0,0),   P1[14],P1[15],0.f,0.f,       pw3[2]=PKW(P1,12),pw3[3]=PKW(P1,14), pw3); \
    l_reg+=sacc; \
    if(GK){DMA_K((t)+3,sl_cur);} if(GV){DMA_V((t)+1,sl_next);} \
    CMASK(C0,C1,t); \
    { float a=MX3(C0[0],C0[1],C1[0]),b=MX3(C0[2],C0[3],C1[1]); a=MX3(a,C1[2],C1[3]); \
      _Pragma("unroll") for(int r=4;r<16;r+=4){a=MX3(a,C0[r],C0[r+1]);b=MX3(b,C0[r+2],C0[r+3]);a=MX3(a,C1[r],C1[r+1]);b=MX3(b,C1[r+2],C1[r+3]);} \
      float rm=__builtin_fmaxf(a,b); { auto rr=__builtin_amdgcn_permlane32_swap(__float_as_uint(rm),__float_as_uint(rm),false,false); rm=__builtin_fmaxf(__uint_as_float(rr[0]),__uint_as_float(rr[1])); } \
      resc=false; \
      if(__builtin_expect(__any(rm>(float)THRL),0)){ const float dl=__builtin_fmaxf(rm,0.f); mhat+=dl; \
        _Pragma("unroll") for(int r=0;r<16;++r){C0[r]-=dl;C1[r]-=dl;} \
        _Pragma("unroll") for(int r=0;r<16;++r)negm[r]=-mhat; asm volatile("":"+v"(negm)); \
        const float f=__builtin_amdgcn_exp2f(-dl); l_reg*=f; if(hi==0)wsf[r32]=f; resc=true; } } \
    SBAR(); \
    GAPB(o[0]=__builtin_amdgcn_mfma_f32_32x32x16_bf16(PAF(0),VFR(0),o[0],0,0,0), C0,0); \
    GAPB(o[1]=__builtin_amdgcn_mfma_f32_32x32x16_bf16(PAF(0),VFR(4),o[1],0,0,0), C0,4); \
    KRD(GL,0); GAPB(o[0]=__builtin_amdgcn_mfma_f32_32x32x16_bf16(PAF(1),VFR(1),o[0],0,0,0), C0,8); \
    KRD(GL,1); GAPB(o[1]=__builtin_amdgcn_mfma_f32_32x32x16_bf16(PAF(1),VFR(5),o[1],0,0,0), C0,12); \
    KRD(GL,2); GAPB(o[0]=__builtin_amdgcn_mfma_f32_32x32x16_bf16(PAF(2),VFR(2),o[0],0,0,0), C1,0); \
    KRD(GL,3); GAPB(o[1]=__builtin_amdgcn_mfma_f32_32x32x16_bf16(PAF(2),VFR(6),o[1],0,0,0), C1,4); \
    GAPB(o[0]=__builtin_amdgcn_mfma_f32_32x32x16_bf16(PAF(3),VFR(3),o[0],0,0,0), C1,8); \
    GAPB(o[1]=__builtin_amdgcn_mfma_f32_32x32x16_bf16(PAF(3),VFR(7),o[1],0,0,0), C1,12); \
    }while(0)
  int t=1;
  #undef CMASK
  #define CMASK(P0,P1,t) do{}while(0)
  for(;t+5<NT;t+=2){
    STEP(pB0,pB1,pA0,pA1,t,true,true,true);     WAIT_BAR(2); RESC(); ROT();
    STEP(pA0,pA1,pB0,pB1,t+1,true,true,true);   WAIT_BAR(2); RESC(); ROT();
  }
  #undef CMASK
  #define CMASK(P0,P1,t) do{int jb_=(t)-(NT-4); if(jb_>=0)cmask(P0,P1,jb_,qrel,hi);}while(0)
  #define ENDW(tt) do{ if((tt)+3<NT){WAIT_BAR(2);} else if((tt)+2<NT){WAIT_BAR(1);} else {WAIT_BAR(0);} }while(0)
  for(;t+1<NT;t+=2){
    STEP(pB0,pB1,pA0,pA1,t,(t+3<NT),(t+1<NT),(t+1<NT));       ENDW(t);   RESC(); ROT();
    STEP(pA0,pA1,pB0,pB1,t+1,(t+4<NT),(t+2<NT),(t+2<NT));     ENDW(t+1); RESC(); ROT();
  }
  STEP(pB0,pB1,pA0,pA1,NT-1,false,false,false); RESC();
  { float sacc=pB0[0]+pB0[1]; _Pragma("unroll") for(int r=2;r<16;++r)sacc+=pB0[r]; _Pragma("unroll") for(int r=0;r<16;++r)sacc+=pB1[r]; l_reg+=sacc;
    pw0=(u32x4){PKW(pB0,0),PKW(pB0,2),PKW(pB0,4),PKW(pB0,6)};pw1=(u32x4){PKW(pB0,8),PKW(pB0,10),PKW(pB0,12),PKW(pB0,14)};pw2=(u32x4){PKW(pB1,0),PKW(pB1,2),PKW(pB1,4),PKW(pB1,6)};pw3=(u32x4){PKW(pB1,8),PKW(pB1,10),PKW(pB1,12),PKW(pB1,14)};
    SBAR(); pv(o,vb0+sl_cur,PAF(0),PAF(1),PAF(2),PAF(3)); }
  #undef PKW
  #undef PAF
  #undef VFR
  #undef PIN
  #undef MX3
  #undef GAPA
  #undef GAPB
  #undef EX
  #undef VRD
  #undef KRD
  #undef STEP
  #undef ENDW
  {auto rr=__builtin_amdgcn_permlane32_swap(__float_as_uint(l_reg),__float_as_uint(l_reg),false,false);l_reg=__uint_as_float(rr[0])+__uint_as_float(rr[1]);}
  if(hi==0)wsf[32+r32]=l_reg;asm volatile("s_waitcnt lgkmcnt(0)":::"memory");
  float rli[16];
  #pragma unroll
  for(int r=0;r<16;++r)rli[r]=__builtin_amdgcn_rcpf(wsf[32+crow(r,hi)]);
  bf16*Ow=O+(rowbase+q0+wid*QBLK)*OP+ocol;
  { bf16*stg=(bf16*)(shm+LDS_OST)+wid*2048;
    #pragma unroll
    for(int r=0;r<16;++r){const int orow=crow(r,hi);
      #pragma unroll
      for(int d0=0;d0<2;++d0)stg[orow*64+d0*32+r32]=__float2bfloat16(o[d0][r]*rli[r]);}
    asm volatile("s_waitcnt lgkmcnt(0)":::"memory");
    #pragma unroll
    for(int i=0;i<4;++i){const int row=i*8+(lane>>3),ch=lane&7; const u32x4 v=*(const u32x4*)(stg+row*64+ch*8); ATTN_STORE16(Ow+(long)row*OP+ch*8,v);} }
  asm volatile("s_waitcnt lgkmcnt(0)\n\ts_barrier":::"memory");
  #undef DMA_K
  #undef DMA_V
  #undef CMASK
  #undef START
  #undef RESC
  #undef ROT
}
constexpr int ATTN_LDS_BYTES=LDS_BYTES;
struct AttnTensors { const bf16* Q; const bf16* K; const bf16* V; bf16* O; };
struct AttnUnit { int bvh; int qb; };
struct StaticOrder {
  int vcu;
  __device__ __forceinline__ explicit StaticOrder(int grid,int block):vcu((block%8)*(grid/8)+block/8){}
  __device__ __forceinline__ bool next(int i,AttnUnit&u)const{ if(i>=4)return false; const int s=vcu&3; u.bvh=vcu>>2; u.qb=(i==0)?s:(i==1)?7-s:(i==2)?8+s:15-s; return true; }
  __device__ __forceinline__ void a_ready(const AttnUnit&)const{}
  __device__ __forceinline__ void done(const AttnUnit&)const{}
};
template<class Sched,int THRL=8> __device__ __forceinline__ void attn_phase(char*lds,const AttnTensors&T,const Sched&S){
  AttnUnit u;
  for(int i=0;S.next(i,u);++i){ S.a_ready(u); const int vh=u.bvh&15,hc=(vh>>1)*64;
    attn_unit<THRL>(u.bvh>>4,hc,hc,(vh>>2)*128+(vh&1)*64,vh*64,u.qb,T.Q,T.K,T.V,T.O,lds); S.done(u); }
}
#undef SBAR
#undef WAIT_BAR
}
#define GAS __attribute__((address_space(1)))
#define LAS __attribute__((address_space(3)))
typedef unsigned short bf16;
typedef unsigned v4u __attribute__((ext_vector_type(4)));
typedef float f32x4 __attribute__((ext_vector_type(4)));
typedef short bf16x8 __attribute__((ext_vector_type(8)));
typedef GAS unsigned gu32;
typedef GAS unsigned long long gu64;
#define RLX_AGENT __ATOMIC_RELAXED, __HIP_MEMORY_SCOPE_AGENT
#define LDS_WAIT() asm volatile("s_waitcnt lgkmcnt(0)" ::: "memory")
#define VM_WAIT() asm volatile("s_waitcnt vmcnt(0)" ::: "memory")
__device__ __forceinline__ unsigned long long rt() { return __builtin_amdgcn_s_memrealtime(); }
__device__ __forceinline__ unsigned f2bf(float f) { unsigned u = __builtin_bit_cast(unsigned, f); return (u + 0x7fffu + ((u >> 16) & 1u)) >> 16; }
__device__ __forceinline__ unsigned pk2(float lo, float hi) { return f2bf(lo) | (f2bf(hi) << 16); }

#define XB_TMO      128
#define XB_XCNT(j)  (256  + 64 * (j))
#define XB_XSUB(j)  (1280 + 64 * (j))
#define XB_XGEN(j)  (2304 + 64 * (j))
#define XB_TOP      3328
#define XB_TOPGEN   3392
#define XCD_BAR_WORDS 3456
#define XB_SPIN_CAP (1u << 18)

__device__ __forceinline__ unsigned xb_ld(unsigned* p)              { return __hip_atomic_load(p, __ATOMIC_RELAXED, __HIP_MEMORY_SCOPE_AGENT); }
__device__ __forceinline__ unsigned xb_add(unsigned* p, unsigned v) { return __hip_atomic_fetch_add(p, v, __ATOMIC_RELAXED, __HIP_MEMORY_SCOPE_AGENT); }
__device__ __forceinline__ unsigned xb_xcc_id() { return (unsigned)__builtin_amdgcn_s_getreg((3 << 11) | 20) & 0xFu; }
#define XB_SPIN(cond, bar) do { unsigned _sp = 0; while (cond) { __builtin_amdgcn_s_sleep(1); \
    if ((++_sp & 255u) == 0u) { if (xb_ld(&(bar)[XB_TMO])) break; if (_sp > XB_SPIN_CAP) { atomicAdd(&(bar)[XB_TMO], 1u); break; } } } } while (0)

struct XcdBarrier {
    unsigned* bar; unsigned x;
    volatile LAS unsigned* st;
};

__device__ __forceinline__ XcdBarrier xcd_barrier_post(unsigned* bar, volatile LAS unsigned* st) {
    XcdBarrier b; b.bar = bar; b.x = xb_xcc_id(); b.st = st;
    if (threadIdx.x == 0) (void)xb_add(&bar[XB_XCNT(b.x)], 1u);
    return b;
}
__device__ __forceinline__ void xcd_barrier_complete(unsigned* bar, unsigned x, unsigned& nloc, unsigned& nx) {
    const unsigned G = gridDim.x * gridDim.y * gridDim.z;
    unsigned sum, cnt, mine, sp = 0u;
    for (;;) {
        sum = 0u; cnt = 0u; mine = 0u;
#pragma unroll
        for (unsigned j = 0; j < 16; ++j) { const unsigned c = xb_ld(&bar[XB_XCNT(j)]); sum += c; cnt += (c > 0u) ? 1u : 0u; mine = (j == x) ? c : mine; }
        if (sum == G) break;
        __builtin_amdgcn_s_sleep(1);
        if ((++sp & 255u) == 0u) { if (xb_ld(&bar[XB_TMO])) break; if (sp > XB_SPIN_CAP) { atomicAdd(&bar[XB_TMO], 1u); break; } }
    }
    nloc = mine > 0u ? mine : 1u; nx = cnt > 0u ? cnt : 1u;
}

__device__ __forceinline__ void xcd_barrier(const XcdBarrier& b) {
    asm volatile("s_waitcnt vmcnt(0)" ::: "memory");
    __syncthreads();
    if (threadIdx.x == 0) {
        unsigned* bar = b.bar;
        __builtin_amdgcn_s_waitcnt(0);
        unsigned nloc = b.st[0], nx = b.st[1];
        if (nloc == 0u) { xcd_barrier_complete(bar, b.x, nloc, nx); b.st[0] = nloc; b.st[1] = nx; }
        const unsigned old = xb_add(&bar[XB_XSUB(b.x)], 1u);
        const unsigned gen = old / nloc;
        if (old + 1u == (gen + 1u) * nloc) {
            __builtin_amdgcn_fence(__ATOMIC_RELEASE, "agent");
            asm volatile("s_waitcnt vmcnt(0)" ::: "memory");
            const unsigned og = xb_add(&bar[XB_TOP], 1u);
            const unsigned tg = og / nx;
            if (og + 1u == (tg + 1u) * nx) xb_add(&bar[XB_TOPGEN], 1u);
            else XB_SPIN(xb_ld(&bar[XB_TOPGEN]) == tg, bar);
            __builtin_amdgcn_fence(__ATOMIC_ACQUIRE, "agent");
            xb_add(&bar[XB_XGEN(b.x)], 1u);
            asm volatile("s_waitcnt vmcnt(0)" ::: "memory");
        } else {
            XB_SPIN(xb_ld(&bar[XB_XGEN(b.x)]) == gen, bar);
            __builtin_amdgcn_fence(__ATOMIC_ACQUIRE, "agent");
            asm volatile("s_waitcnt vmcnt(0)" ::: "memory");
        }
    }
    __syncthreads();
}
constexpr int NWAVES = 8;
constexpr int MP = 16384, MS = 256, M = MP + MS;
constexpr int D = 1024, FF = 2816, INC = 4608;
constexpr float RMS_EPS = 1e-6f, LN_EPS = 1e-5f;
constexpr float QSCALE = 0.125f * 1.4426950408889634f;
constexpr int DEC_NS = 8;
constexpr size_t O_Y = 0, O_KP = 17039360, O_VP = 25427968, O_SP = 33816576, O_KS = 34078720, O_VS = 34209792, O_SS = 34340864, O_END = 34471936;
constexpr size_t KiB = 1024, MiB = 1u << 20;
constexpr size_t WS_CTL = 0, CTL_ZERO_BYTES = 1 * MiB;
constexpr size_t WS_W1T = 1 * MiB;
constexpr size_t WS_W2T = WS_W1T + (size_t)5632 * 1024 * 2;
constexpr size_t WS_WINT = WS_W2T + (size_t)1024 * 2816 * 2;
constexpr size_t WS_WPAT = WS_WINT + (size_t)4608 * 1024 * 2;
constexpr size_t WS_WPBT = WS_WPAT + (size_t)1024 * 512 * 2;
constexpr size_t WS_WOT = WS_WPBT + (size_t)1024 * 512 * 2;
constexpr size_t WS_W3T = WS_WOT + (size_t)1024 * 1024 * 2;
constexpr size_t WS_W4T = WS_W3T + (size_t)5632 * 1024 * 2;
constexpr size_t WS_XB = WS_W4T + (size_t)1024 * 2816 * 2;
constexpr size_t WS_SSX = WS_XB + (size_t)M * 1024 * 2;
constexpr size_t WS_ACT = WS_SSX + (size_t)M * 16 * 4;
constexpr size_t WS_H = WS_ACT + (size_t)M * 2816 * 2;
constexpr size_t WS_HB = WS_H + (size_t)M * 1024 * 4;
constexpr size_t WS_SSH = WS_HB + (size_t)M * 1024 * 2;
constexpr size_t WS_QB = WS_SSH + (size_t)M * 16 * 4;
constexpr size_t WS_KB = WS_QB + (size_t)M * 512 * 2;
constexpr size_t WS_VB = WS_KB + (size_t)M * 512 * 2;
constexpr size_t WS_UG = WS_VB + (size_t)M * 512 * 2;
constexpr size_t WS_VG = WS_UG + (size_t)M * 512 * 2;
constexpr size_t WS_VGS = WS_VG + (size_t)M * 512 * 4;
constexpr size_t WS_GA = WS_VGS + (size_t)M * 16 * 4;
constexpr size_t WS_GB = WS_GA + (size_t)M * 1024 * 2;
constexpr size_t WS_OV = WS_GB + (size_t)M * 1024 * 2;
constexpr size_t WS_DP = WS_OV + (size_t)MP * 1024 * 2;
constexpr size_t WS_DML = WS_DP + (size_t)128 * DEC_NS * 16 * 128 * 4;
constexpr size_t WS_AS = WS_DML + (size_t)128 * DEC_NS * 16 * 2 * 4;
constexpr size_t WS_SG = WS_AS + (size_t)M * 512 * 2;
constexpr size_t WS_T1 = WS_SG + (size_t)M * 512 * 2;
constexpr size_t WS_MB = WS_T1 + (size_t)M * 1024 * 4;
constexpr size_t WS_SSO = WS_MB + (size_t)M * 1024 * 2;
constexpr size_t WS_LAM = WS_SSO + (size_t)M * 16 * 4;
constexpr size_t WS_OPT_END = WS_LAM + 256;
static_assert(WS_W1T % 256 == 0 && WS_XB % 256 == 0 && WS_ACT % 256 == 0 && WS_H % 256 == 0 && WS_QB % 256 == 0 && WS_VG % 256 == 0 && WS_OV % 256 == 0 && WS_DP % 256 == 0 && WS_AS % 256 == 0 && WS_T1 % 256 == 0 && WS_LAM % 256 == 0, "ws alignment");
constexpr int CW_BAR = 4096;
constexpr int RING_OFF = 0, RING_BYTES = 131072;
constexpr int LDSCTL_OFF = RING_BYTES, MISC_OFF = LDSCTL_OFF + 320;
constexpr int LDS_BYTES = 147456;
typedef unsigned u32x2v __attribute__((ext_vector_type(2)));
#define MFMA16(a, b, c) __builtin_amdgcn_mfma_f32_16x16x32_bf16(a, b, c, 0, 0, 0)
__device__ __forceinline__ float bf_lo(unsigned w) { return __uint_as_float(w << 16); }
__device__ __forceinline__ float bf_hi(unsigned w) { return __uint_as_float(w & 0xffff0000u); }
__device__ __forceinline__ float wave_sum(float v) {
#pragma unroll
    for (int o = 1; o < 64; o <<= 1) v += __shfl_xor(v, o);
    return v;
}
__device__ __forceinline__ void p0_item(const float* W, int ldw, int K, bf16* WT, const float* gain, LAS float* scr, int k0, int n0, int sc0, int lane) {
#pragma unroll 8
    for (int i = 0; i < 32; ++i) { const int kk = 2 * i + (lane >> 5); float w = W[(size_t)(k0 + kk) * ldw + sc0 + (lane & 31)]; if (gain) w *= gain[k0 + kk]; scr[kk * 33 + (lane & 31)] = w; }
    LDS_WAIT(); asm volatile("" ::: "memory");
    const int c = lane & 7;
#pragma unroll
    for (int j = 0; j < 4; ++j) { const int n = (lane >> 3) + 8 * j; const LAS float* s = scr + (8 * c) * 33 + n;
        v4u o; o.x = pk2(s[0 * 33], s[1 * 33]); o.y = pk2(s[2 * 33], s[3 * 33]); o.z = pk2(s[4 * 33], s[5 * 33]); o.w = pk2(s[6 * 33], s[7 * 33]);
        *(GAS v4u*)(WT + (size_t)(n0 + n) * K + k0 + 8 * c) = o; }
    LDS_WAIT(); asm volatile("" ::: "memory");
}
__device__ __forceinline__ bool p0_matrix(int& r, const float* W, int ldw, int K, int N, bf16* WT, const float* gain, bool swiglu, LAS float* scr, int lane) {
    const int nblk = N / 32, items = (K / 64) * nblk;
    if (r >= items) { r -= items; return false; }
    const int kb = r / nblk, nb = r % nblk, n0 = 32 * nb; const int sc0 = swiglu ? ((n0 >> 7) & 1) * 2816 + (n0 >> 8) * 128 + (n0 & 127) : n0;
    p0_item(W, ldw, K, WT, gain, scr, 64 * kb, n0, sc0, lane); return true;
}
struct P0Args { const float *xp, *xs, *n1, *f1i, *f1o, *nm, *w_in, *lq1, *lk1, *lq2, *lk2, *wpa, *wpb, *w_out, *n2, *f2i, *f2o; bf16 *W1T, *W2T, *WINT, *WPAT, *WPBT, *WOT, *W3T, *W4T, *XB; float *SSX, *LAM; };
__device__ __forceinline__ void p0_prologue(const P0Args& a, LAS unsigned char* lds, int wave, int lane, int vcu, int G) {
    LAS float* scr = (LAS float*)(lds + wave * 16384);
    const int gw = vcu * NWAVES + wave, NGW = G * NWAVES;
    constexpr int NITEMS = 2 * (16 * 176) + 2 * (44 * 32) + 16 * 144 + 2 * (8 * 32) + 16 * 32;
    for (int it = gw; it < NITEMS; it += NGW) {
        int r = it;
        if (p0_matrix(r, a.f1i, 5632, 1024, 5632, a.W1T, a.n1, true, scr, lane)) continue;
        if (p0_matrix(r, a.f2i, 5632, 1024, 5632, a.W3T, a.n2, true, scr, lane)) continue;
        if (p0_matrix(r, a.f1o, 1024, 2816, 1024, a.W2T, nullptr, false, scr, lane)) continue;
        if (p0_matrix(r, a.f2o, 1024, 2816, 1024, a.W4T, nullptr, false, scr, lane)) continue;
        if (p0_matrix(r, a.w_in, 4608, 1024, 4608, a.WINT, a.nm, false, scr, lane)) continue;
        if (p0_matrix(r, a.wpa, 1024, 512, 1024, a.WPAT, nullptr, false, scr, lane)) continue;
        if (p0_matrix(r, a.wpb, 1024, 512, 1024, a.WPBT, nullptr, false, scr, lane)) continue;
        p0_matrix(r, a.w_out, 1024, 1024, 1024, a.WOT, nullptr, false, scr, lane);
    }
    for (int m = gw; m < M; m += NGW) {
        const float* xr = (m < MP) ? a.xp + (size_t)m * D : a.xs + (size_t)(m - MP) * D;
        const GAS f32x4* xv = (const GAS f32x4*)xr + lane; f32x4 v[4]; float s = 0.f;
#pragma unroll
        for (int j = 0; j < 4; ++j) { v[j] = xv[64 * j]; s += (v[j][0] * v[j][0] + v[j][1] * v[j][1]) + (v[j][2] * v[j][2] + v[j][3] * v[j][3]); }
        s = wave_sum(s);
        GAS unsigned long long* o8 = (GAS unsigned long long*)(a.XB + (size_t)m * D) + lane;
#pragma unroll
        for (int j = 0; j < 4; ++j) o8[64 * j] = (unsigned long long)pk2(v[j][0], v[j][1]) | ((unsigned long long)pk2(v[j][2], v[j][3]) << 32);
        if (lane < 16) a.SSX[(size_t)m * 16 + lane] = (lane == 0) ? s : 0.f;
    }
    if (vcu == 0 && wave == 0 && lane == 0) { float s1 = 0.f, s2 = 0.f; for (int i = 0; i < 64; ++i) { s1 += a.lq1[i] * a.lk1[i]; s2 += a.lq2[i] * a.lk2[i]; } a.LAM[0] = expf(s1) - expf(s2) + 0.2f; }
}
__device__ __forceinline__ void decode_unit(int b, int h, int sp, const bf16* QB, const float* cache_k, const float* cache_v, const int* pt, float* DP, float* DML, LAS unsigned char* lds, int tid) {
    const int lane = tid & 63, wid = __builtin_amdgcn_readfirstlane(tid >> 6), j = lane & 15, g = lane >> 4;
    LAS unsigned char* wl = lds + wid * 10240;
    bf16x8 qf[4];
#pragma unroll
    for (int s = 0; s < 4; ++s) { qf[s] = (bf16x8){0, 0, 0, 0, 0, 0, 0, 0};
        if ((j >> 3) == (s >> 1)) qf[s] = *(const bf16x8*)(QB + (size_t)(MP + b * 8 + (j & 7)) * 512 + h * 128 + s * 32 + g * 8); }
    const int page = __builtin_amdgcn_readfirstlane(pt[b * 64 + sp * 8 + wid]);
    const float* kbase = cache_k + ((size_t)page * 512 + h) * 128 + (lane >> 5) * 16 * 512 + (lane & 31) * 4;
    const float* vbase = cache_v + ((size_t)page * 512 + h) * 128 + (lane >> 5) * 16 * 512 + (lane & 31) * 4;
    f32x4 kreg[16], vreg[16];
#define DEC_ISSUE(reg, base, blk) do { _Pragma("unroll") for (int i_ = 0; i_ < 16; ++i_) reg[i_] = __builtin_nontemporal_load((const f32x4*)((base) + (size_t)((blk) * 32 + i_) * 512)); } while (0)
    DEC_ISSUE(kreg, kbase, 0); DEC_ISSUE(vreg, vbase, 0);
    float m_run = -INFINITY, l_run = 0.f; f32x4 o[8];
#pragma unroll
    for (int cb = 0; cb < 8; ++cb) o[cb] = (f32x4){0.f, 0.f, 0.f, 0.f};
#pragma unroll 1
    for (int blk = 0; blk < 4; ++blk) {
#pragma unroll
        for (int i = 0; i < 16; ++i) { u32x2v w; w.x = pg8::cvt_pk_bf16(kreg[i][0], kreg[i][1]); w.y = pg8::cvt_pk_bf16(kreg[i][2], kreg[i][3]);
            *(LAS u32x2v*)(wl + ((lane >> 5) * 16 + i) * 272 + (lane & 31) * 8) = w; }
        if (blk < 3) DEC_ISSUE(kreg, kbase, blk + 1);
        f32x4 S[2];
#pragma unroll
        for (int T = 0; T < 2; ++T) { S[T] = (f32x4){0.f, 0.f, 0.f, 0.f};
#pragma unroll
            for (int s = 0; s < 4; ++s) { const bf16x8 kf = *(const LAS bf16x8*)(wl + (16 * T + j) * 272 + s * 64 + g * 16); S[T] = MFMA16(kf, qf[s], S[T]); } }
        float bm = fmaxf(fmaxf(fmaxf(S[0][0], S[0][1]), fmaxf(S[0][2], S[0][3])), fmaxf(fmaxf(S[1][0], S[1][1]), fmaxf(S[1][2], S[1][3])));
        bm = fmaxf(bm, __shfl_xor(bm, 16)); bm = fmaxf(bm, __shfl_xor(bm, 32));
        const float m_new = fmaxf(m_run, bm), alpha = __builtin_amdgcn_exp2f(m_run - m_new); m_run = m_new;
        float ps = 0.f;
#pragma unroll
        for (int T = 0; T < 2; ++T)
#pragma unroll
            for (int e = 0; e < 4; ++e) { S[T][e] = __builtin_amdgcn_exp2f(S[T][e] - m_new); ps += S[T][e]; }
        l_run = l_run * alpha + ps;
#pragma unroll
        for (int cb = 0; cb < 8; ++cb) o[cb] = o[cb] * alpha;
        v4u pw; pw.x = pg8::cvt_pk_bf16(S[0][0], S[0][1]); pw.y = pg8::cvt_pk_bf16(S[0][2], S[0][3]); pw.z = pg8::cvt_pk_bf16(S[1][0], S[1][1]); pw.w = pg8::cvt_pk_bf16(S[1][2], S[1][3]);
        const bf16x8 pf = __builtin_bit_cast(bf16x8, pw);
#pragma unroll
        for (int gk = 0; gk < 4; ++gk)
#pragma unroll
            for (int cc = 0; cc < 4; ++cc) { u32x2v w; w.x = pg8::cvt_pk_bf16(vreg[4 * gk][cc], vreg[4 * gk + 1][cc]); w.y = pg8::cvt_pk_bf16(vreg[4 * gk + 2][cc], vreg[4 * gk + 3][cc]);
                *(LAS u32x2v*)(wl + (4 * (lane & 31) + cc) * 80 + (8 * gk + 4 * (lane >> 5)) * 2) = w; }
        if (blk < 3) DEC_ISSUE(vreg, vbase, blk + 1);
#pragma unroll
        for (int cb = 0; cb < 8; ++cb) { const bf16x8 vf = *(const LAS bf16x8*)(wl + (16 * cb + j) * 80 + g * 16); o[cb] = MFMA16(vf, pf, o[cb]); }
    }
#undef DEC_ISSUE
    l_run += __shfl_xor(l_run, 16); l_run += __shfl_xor(l_run, 32);
    __syncthreads();
    LAS float* cw = (LAS float*)lds;
#pragma unroll
    for (int cb = 0; cb < 8; ++cb) *(LAS f32x4*)(cw + (wid * 16 + j) * 132 + 16 * cb + 4 * g) = o[cb];
    if (g == 0) { cw[(wid * 16 + j) * 132 + 128] = m_run; cw[(wid * 16 + j) * 132 + 129] = l_run; }
    __syncthreads();
    { const int q = tid >> 5, c4 = (tid & 31) * 4; float mw[8]; float Mx = -INFINITY;
#pragma unroll
        for (int w = 0; w < 8; ++w) { mw[w] = cw[(w * 16 + q) * 132 + 128]; Mx = fmaxf(Mx, mw[w]); }
        f32x4 acc = (f32x4){0.f, 0.f, 0.f, 0.f}; float L = 0.f;
#pragma unroll
        for (int w = 0; w < 8; ++w) { const float f = __builtin_amdgcn_exp2f(mw[w] - Mx); acc += *(const LAS f32x4*)(cw + (w * 16 + q) * 132 + c4) * f; L += cw[(w * 16 + q) * 132 + 129] * f; }
        const int unit = (b * 4 + h) * DEC_NS + sp;
        *(f32x4*)(DP + ((size_t)unit * 16 + q) * 128 + c4) = acc;
        if ((tid & 31) == 0) { DML[((size_t)unit * 16 + q) * 2] = Mx; DML[((size_t)unit * 16 + q) * 2 + 1] = L; } }
    __syncthreads();
}
struct SpArgs { const float *VG, *VGS, *ln_g, *ln_b, *w_s, *b_s; const bf16* UG; bf16* SG; float* out; };
__device__ __forceinline__ void spatial_unit(int ck, int g, const SpArgs& a, LAS unsigned char* lds, int tid) {
    const int lane = tid & 63, wid = __builtin_amdgcn_readfirstlane(tid >> 6), j = lane & 15, gq = lane >> 4;
    LAS unsigned char* Wt = lds; LAS unsigned char* Vt = lds + 34816; LAS float* st = (LAS float*)(lds + 69632);
    const int R0 = ck * 128;
    if (tid < 128) { const f32x4* p = (const f32x4*)(a.VGS + (size_t)(R0 + tid) * 16); const f32x4 x0 = p[0], x1 = p[1], x2 = p[2], x3 = p[3];
        const float s1 = (x0[0] + x0[2]) + (x1[0] + x1[2]) + (x2[0] + x2[2]) + (x3[0] + x3[2]), s2 = (x0[1] + x0[3]) + (x1[1] + x1[3]) + (x2[1] + x2[3]) + (x3[1] + x3[3]);
        const float mean = s1 * (1.0f / 512.0f), var = s2 * (1.0f / 512.0f) - mean * mean; st[2 * tid] = mean; st[2 * tid + 1] = 1.0f / sqrtf(var + LN_EPS); }
#pragma unroll
    for (int i = 0; i < 8; ++i) { const int idx = tid + 512 * i, t = idx >> 5, s4 = (idx & 31) * 4; f32x4 w = *(const f32x4*)(a.w_s + ((size_t)g * 128 + t) * 128 + s4);
#pragma unroll
        for (int e = 0; e < 4; ++e) if (s4 + e > t) w[e] = 0.f;
        u32x2v p; p.x = pg8::cvt_pk_bf16(w[0], w[1]); p.y = pg8::cvt_pk_bf16(w[2], w[3]); *(LAS u32x2v*)(Wt + t * 272 + s4 * 2) = p; }
    __syncthreads();
    const bool tail = (ck & 31) == 31; const int bb = ck >> 5;
#pragma unroll
    for (int i = 0; i < 8; ++i) { const int idx = tid + 512 * i, s = idx >> 5, e4 = (idx & 31) * 4; const f32x4 x = *(const f32x4*)(a.VG + (size_t)(R0 + s) * 512 + g * 128 + e4);
        const float mean = st[2 * s], rstd = st[2 * s + 1]; const f32x4 gg = *(const f32x4*)(a.ln_g + g * 128 + e4), bv = *(const f32x4*)(a.ln_b + g * 128 + e4);
        const f32x4 v = (x - mean) * rstd * gg + bv;
        if (tail) *(f32x4*)(a.out + O_SP + ((size_t)bb * 128 + s) * 512 + g * 128 + e4) = v;
#pragma unroll
        for (int cc = 0; cc < 4; ++cc) *(LAS unsigned short*)(Vt + (e4 + cc) * 272 + s * 2) = (unsigned short)f2bf(v[cc]); }
    __syncthreads();
    f32x4 acc[8];
#pragma unroll
    for (int eb = 0; eb < 8; ++eb) acc[eb] = (f32x4){0.f, 0.f, 0.f, 0.f};
#pragma unroll
    for (int ks = 0; ks < 4; ++ks) { const bf16x8 wf = *(const LAS bf16x8*)(Wt + (16 * wid + j) * 272 + ks * 64 + gq * 16);
#pragma unroll
        for (int eb = 0; eb < 8; ++eb) { const bf16x8 vf = *(const LAS bf16x8*)(Vt + (16 * eb + j) * 272 + ks * 64 + gq * 16); acc[eb] = MFMA16(vf, wf, acc[eb]); } }
    { const int t = 16 * wid + j; const float bias = a.b_s[g * 128 + t]; const size_t ro = (size_t)(R0 + t) * 512 + g * 128 + 4 * gq;
#pragma unroll
        for (int eb = 0; eb < 8; ++eb) { const u32x2v ug = *(const u32x2v*)(a.UG + ro + 16 * eb); const f32x4 v = acc[eb] + bias;
            u32x2v w; w.x = pg8::cvt_pk_bf16(bf_lo(ug.x) * v[0], bf_hi(ug.x) * v[1]); w.y = pg8::cvt_pk_bf16(bf_lo(ug.y) * v[2], bf_hi(ug.y) * v[3]); *(u32x2v*)(a.SG + ro + 16 * eb) = w; } }
    __syncthreads();
}
__device__ __forceinline__ void spatial_sample_unit(int b, const SpArgs& a, int tid) {
    const int g = tid >> 7; float vs[8];
#pragma unroll
    for (int s = 0; s < 8; ++s) { const int row = MP + b * 8 + s; const f32x4* p = (const f32x4*)(a.VGS + (size_t)row * 16); const f32x4 x0 = p[0], x1 = p[1], x2 = p[2], x3 = p[3];
        const float s1 = (x0[0] + x0[2]) + (x1[0] + x1[2]) + (x2[0] + x2[2]) + (x3[0] + x3[2]), s2 = (x0[1] + x0[3]) + (x1[1] + x1[3]) + (x2[1] + x2[3]) + (x3[1] + x3[3]);
        const float mean = s1 * (1.0f / 512.0f), var = s2 * (1.0f / 512.0f) - mean * mean, rstd = 1.0f / sqrtf(var + LN_EPS);
        vs[s] = (a.VG[(size_t)row * 512 + tid] - mean) * rstd * a.ln_g[tid] + a.ln_b[tid];
        a.out[O_SS + (size_t)(b * 8 + s) * 512 + tid] = vs[s]; }
#pragma unroll
    for (int t = 0; t < 8; ++t) { float acc = a.b_s[g * 128 + t];
#pragma unroll
        for (int s = 0; s < 8; ++s) if (s <= t) acc += a.w_s[((size_t)g * 128 + t) * 128 + s] * vs[s];
        const size_t o = (size_t)(MP + b * 8 + t) * 512 + tid; const float ug = __uint_as_float((unsigned)a.UG[o] << 16);
        a.SG[o] = (bf16)f2bf(ug * acc); }
}
__device__ __forceinline__ void combine_prompt(const bf16* OV, const float* subln, float lam, bf16* AS, int gw, int NGW, int lane) {
    const int h = lane >> 4, q = lane & 15, e = q >> 3, d = (q & 7) * 8;
    const f32x4 g0 = *(const f32x4*)(subln + e * 64 + d), g1 = *(const f32x4*)(subln + e * 64 + d + 4);
    for (int m = gw; m < MP; m += NGW) {
        const v4u a1 = *(const v4u*)(OV + (size_t)m * 1024 + (h * 4 + e) * 64 + d), a2 = *(const v4u*)(OV + (size_t)m * 1024 + (h * 4 + 2 + e) * 64 + d);
        float o[8]; o[0] = bf_lo(a1.x) - lam * bf_lo(a2.x); o[1] = bf_hi(a1.x) - lam * bf_hi(a2.x); o[2] = bf_lo(a1.y) - lam * bf_lo(a2.y); o[3] = bf_hi(a1.y) - lam * bf_hi(a2.y);
        o[4] = bf_lo(a1.z) - lam * bf_lo(a2.z); o[5] = bf_hi(a1.z) - lam * bf_hi(a2.z); o[6] = bf_lo(a1.w) - lam * bf_lo(a2.w); o[7] = bf_hi(a1.w) - lam * bf_hi(a2.w);
        float ss = 0.f;
#pragma unroll
        for (int i = 0; i < 8; ++i) ss += o[i] * o[i];
        ss += __shfl_xor(ss, 1); ss += __shfl_xor(ss, 2); ss += __shfl_xor(ss, 4); ss += __shfl_xor(ss, 8);
        const float r = 0.8f / sqrtf(ss * (1.0f / 128.0f) + RMS_EPS);
        v4u w; w.x = pk2(o[0] * r * g0[0], o[1] * r * g0[1]); w.y = pk2(o[2] * r * g0[2], o[3] * r * g0[3]); w.z = pk2(o[4] * r * g1[0], o[5] * r * g1[1]); w.w = pk2(o[6] * r * g1[2], o[7] * r * g1[3]);
        *(v4u*)(AS + (size_t)m * 512 + h * 128 + e * 64 + d) = w;
    }
}
__device__ __forceinline__ void combine_sample(int b, int h, const bf16* QB, const float* out, const float* DP, const float* DML, const float* subln, float lam, bf16* AS, LAS unsigned char* lds, int tid) {
    const int q = tid >> 5, cg = tid & 31, c4 = cg * 4, c = q >> 3, t = q & 7;
    const unsigned qw = *(const unsigned*)(QB + (size_t)(MP + b * 8 + t) * 512 + h * 128 + c * 64 + 2 * cg); const float q0 = bf_lo(qw), q1 = bf_hi(qw);
    float sn[8];
#pragma unroll
    for (int t2 = 0; t2 < 8; ++t2) { const float* kp = out + O_KS + (size_t)(b * 8 + t2) * 512 + h * 128 + c * 64 + 2 * cg; float s = q0 * kp[0] + q1 * kp[1];
        s += __shfl_xor(s, 1); s += __shfl_xor(s, 2); s += __shfl_xor(s, 4); s += __shfl_xor(s, 8); s += __shfl_xor(s, 16); sn[t2] = (t2 <= t) ? s : -INFINITY; }
    const int unit0 = (b * 4 + h) * DEC_NS; float mw[DEC_NS], lw[DEC_NS]; float Mx = -INFINITY;
#pragma unroll
    for (int sp = 0; sp < DEC_NS; ++sp) { mw[sp] = DML[((size_t)(unit0 + sp) * 16 + q) * 2]; lw[sp] = DML[((size_t)(unit0 + sp) * 16 + q) * 2 + 1]; Mx = fmaxf(Mx, mw[sp]); }
#pragma unroll
    for (int t2 = 0; t2 < 8; ++t2) Mx = fmaxf(Mx, sn[t2]);
    f32x4 acc = (f32x4){0.f, 0.f, 0.f, 0.f}; float L = 0.f;
#pragma unroll
    for (int sp = 0; sp < DEC_NS; ++sp) { const float f = __builtin_amdgcn_exp2f(mw[sp] - Mx); acc += *(const f32x4*)(DP + ((size_t)(unit0 + sp) * 16 + q) * 128 + c4) * f; L += lw[sp] * f; }
#pragma unroll
    for (int t2 = 0; t2 < 8; ++t2) { const float p = __builtin_amdgcn_exp2f(sn[t2] - Mx); acc += *(const f32x4*)(out + O_VS + (size_t)(b * 8 + t2) * 512 + h * 128 + c4) * p; L += p; }
    LAS float* ol = (LAS float*)lds;
    *(LAS f32x4*)(ol + q * 128 + c4) = acc * (1.0f / L);
    __syncthreads();
    if (q < 8) { const f32x4 of = *(const LAS f32x4*)(ol + t * 128 + c4) - *(const LAS f32x4*)(ol + (8 + t) * 128 + c4) * lam;
        float ss = (of[0] * of[0] + of[1] * of[1]) + (of[2] * of[2] + of[3] * of[3]);
        ss += __shfl_xor(ss, 1); ss += __shfl_xor(ss, 2); ss += __shfl_xor(ss, 4); ss += __shfl_xor(ss, 8); ss += __shfl_xor(ss, 16);
        const float r = 0.8f / sqrtf(ss * (1.0f / 128.0f) + RMS_EPS); const f32x4 gsl = *(const f32x4*)(subln + c4);
        u32x2v w; w.x = pk2(of[0] * r * gsl[0], of[1] * r * gsl[1]); w.y = pk2(of[2] * r * gsl[2], of[3] * r * gsl[3]);
        *(u32x2v*)(AS + (size_t)(MP + b * 8 + t) * 512 + h * 128 + c4) = w; }
    __syncthreads();
}
__device__ __forceinline__ void final_norm(float* y, const float* ss, const float* nf, int gw, int NGW, int lane) {
    f32x4 gv[4];
#pragma unroll
    for (int jx = 0; jx < 4; ++jx) gv[jx] = *((const f32x4*)nf + lane + 64 * jx);
    for (int m = gw; m < M; m += NGW) { const f32x4* p = (const f32x4*)(ss + (size_t)m * 16); const f32x4 a = p[0], b = p[1], c = p[2], d = p[3];
        const float s = (pg8::hsum4(a) + pg8::hsum4(b)) + (pg8::hsum4(c) + pg8::hsum4(d)), r = 1.0f / sqrtf(s * (1.0f / 1024.0f) + RMS_EPS);
        f32x4* yr = (f32x4*)(y + (size_t)m * D) + lane;
#pragma unroll
        for (int jx = 0; jx < 4; ++jx) yr[64 * jx] = yr[64 * jx] * r * gv[jx]; }
}

template <int KSTEPS  > __device__ __forceinline__ void thin_tile(const bf16* A, int lda, const bf16* Bt, int ldb, int tl, LAS float* red, int tid) {
    const int lane = tid & 63, wid = __builtin_amdgcn_readfirstlane(tid >> 6), i = lane & 15, g = lane >> 4;
    const int r0 = MP + 16 * (tl >> 4), c0 = 64 * (tl & 15), k0 = wid * KSTEPS * 32 + 8 * g;
    const bf16* ap = A + (size_t)(r0 + i) * lda + k0; const bf16* bp = Bt + (size_t)(c0 + i) * ldb + k0;
    f32x4 acc[4];
#pragma unroll
    for (int nb = 0; nb < 4; ++nb) acc[nb] = (f32x4){0.f, 0.f, 0.f, 0.f};
#pragma unroll 4
    for (int s = 0; s < KSTEPS; ++s) { const bf16x8 af = *(const bf16x8*)(ap + 32 * s);
#pragma unroll
        for (int nb = 0; nb < 4; ++nb) { const bf16x8 bfr = *(const bf16x8*)(bp + (size_t)(16 * nb) * ldb + 32 * s); acc[nb] = MFMA16(bfr, af, acc[nb]); } }
#pragma unroll
    for (int nb = 0; nb < 4; ++nb) *(LAS f32x4*)(red + (wid * 16 + i) * 64 + 16 * nb + 4 * g) = acc[nb];
    __syncthreads();
    { const int row = tid >> 5, c2 = (tid & 31) * 2; float v0 = 0.f, v1 = 0.f;
#pragma unroll
        for (int w = 0; w < 8; ++w) { v0 += red[(w * 16 + row) * 64 + c2]; v1 += red[(w * 16 + row) * 64 + c2 + 1]; }
        __syncthreads();
        red[row * 64 + c2] = v0; red[row * 64 + c2 + 1] = v1; }
    __syncthreads();
}
__device__ __forceinline__ void thin_res(const LAS float* red, int tl, const float* base, float* out, bf16* outb, float* ss, float scale, int tid) {
    const int row = tid >> 5, c2 = (tid & 31) * 2; const size_t r = (size_t)(MP + 16 * (tl >> 4) + row), o = r * 1024 + 64 * (tl & 15) + c2;
    const float v0 = base[o] + scale * red[row * 64 + c2], v1 = base[o + 1] + scale * red[row * 64 + c2 + 1];
    out[o] = v0; out[o + 1] = v1; if (outb) *(unsigned*)(outb + o) = pk2(v0, v1);
    float q = v0 * v0 + v1 * v1; q += __shfl_xor(q, 1); q += __shfl_xor(q, 2); q += __shfl_xor(q, 4); q += __shfl_xor(q, 8); q += __shfl_xor(q, 16);
    if ((tid & 31) == 0) ss[r * 16 + (tl & 15)] = q;
}

struct Args { const void* in[26]; float* out; unsigned char* ws; int ph_lo, ph_hi; };
constexpr int N_PHASES = 11;
__global__ void __launch_bounds__(NWAVES * 64, 2) mega_fwd(Args args) {
    extern __shared__ __attribute__((aligned(16))) unsigned char lds_raw[];
    LAS unsigned char* lds = (LAS unsigned char*)lds_raw;
    const int tid = threadIdx.x, lane = tid & 63, wave = __builtin_amdgcn_readfirstlane(tid >> 6);
    const int G = gridDim.x; const int bx = blockIdx.x; const int vcu = (G % 8 == 0) ? (bx % 8) * (G / 8) + bx / 8 : bx;
    const int gw = vcu * NWAVES + wave, NGW = G * NWAVES;
    unsigned char* ws = args.ws; float* out = args.out;
    gu32* ctl = (gu32*)(ws + WS_CTL);
    const float* x_prompt = (const float*)args.in[0]; const float* x_sample = (const float*)args.in[1];
    const float* cache_k = (const float*)args.in[2]; const float* cache_v = (const float*)args.in[3]; const int* page_table = (const int*)args.in[4];
    bf16 *W1T = (bf16*)(ws + WS_W1T), *W2T = (bf16*)(ws + WS_W2T), *WINT = (bf16*)(ws + WS_WINT), *WPAT = (bf16*)(ws + WS_WPAT), *WPBT = (bf16*)(ws + WS_WPBT), *WOT = (bf16*)(ws + WS_WOT), *W3T = (bf16*)(ws + WS_W3T), *W4T = (bf16*)(ws + WS_W4T);
    bf16 *XB = (bf16*)(ws + WS_XB), *ACT = (bf16*)(ws + WS_ACT), *HB = (bf16*)(ws + WS_HB), *QB = (bf16*)(ws + WS_QB), *KB = (bf16*)(ws + WS_KB), *VB = (bf16*)(ws + WS_VB), *UG = (bf16*)(ws + WS_UG);
    bf16 *GA = (bf16*)(ws + WS_GA), *GB = (bf16*)(ws + WS_GB), *OV = (bf16*)(ws + WS_OV), *AS = (bf16*)(ws + WS_AS), *SG = (bf16*)(ws + WS_SG), *MB = (bf16*)(ws + WS_MB);
    float *SSX = (float*)(ws + WS_SSX), *H = (float*)(ws + WS_H), *SSH = (float*)(ws + WS_SSH), *VG = (float*)(ws + WS_VG), *VGS = (float*)(ws + WS_VGS), *DP = (float*)(ws + WS_DP), *DML = (float*)(ws + WS_DML);
    float *T1 = (float*)(ws + WS_T1), *SSO = (float*)(ws + WS_SSO), *LAM = (float*)(ws + WS_LAM);
    for (int u = tid; u < (LDS_BYTES - LDSCTL_OFF) / 4; u += NWAVES * 64) ((LAS unsigned*)(lds + LDSCTL_OFF))[u] = 0u;
    __syncthreads();
    const int lo = args.ph_lo, hi = args.ph_hi;
    const bool use_bar = (hi - lo) > 1;
    XcdBarrier bar; bar.bar = (unsigned*)(ctl + CW_BAR); bar.x = 0; bar.st = nullptr;
    if (use_bar) bar = xcd_barrier_post((unsigned*)(ctl + CW_BAR), (volatile LAS unsigned*)(lds + MISC_OFF) + 8);
#ifndef PHASE_MASK
#define PHASE_MASK 0x7ff
#endif
#define IN(k) (((PHASE_MASK >> (k)) & 1) && lo <= (k) && (k) < hi)
#define SEAM(k) do { if (IN(k) && IN((k) + 1)) xcd_barrier(bar); } while (0)

    if (IN(0)) {
        P0Args a; a.xp = x_prompt; a.xs = x_sample; a.n1 = (const float*)args.in[5]; a.f1i = (const float*)args.in[6]; a.f1o = (const float*)args.in[7]; a.nm = (const float*)args.in[8]; a.w_in = (const float*)args.in[9];
        a.lq1 = (const float*)args.in[10]; a.lk1 = (const float*)args.in[11]; a.lq2 = (const float*)args.in[12]; a.lk2 = (const float*)args.in[13];
        a.wpa = (const float*)args.in[19]; a.wpb = (const float*)args.in[20]; a.w_out = (const float*)args.in[21]; a.n2 = (const float*)args.in[22]; a.f2i = (const float*)args.in[23]; a.f2o = (const float*)args.in[24];
        a.W1T = W1T; a.W2T = W2T; a.WINT = WINT; a.WPAT = WPAT; a.WPBT = WPBT; a.WOT = WOT; a.W3T = W3T; a.W4T = W4T; a.XB = XB; a.SSX = SSX; a.LAM = LAM;
        p0_prologue(a, lds, wave, lane, vcu, G);
    }
    SEAM(0);
    if (IN(1)) { pg8::Gemm g{XB, W1T, M, 2 * FF, D}; pg8::StaticOrder S; S.init(M, 2 * FF, G, bx); pg8::EpiSwiglu E{ACT, SSX};
        pg8::gemm_phase<pg8::EpiSwiglu, pg8::StaticOrder, true, true>(lds + RING_OFF, g, S, E); }
    SEAM(1);
    if (IN(2)) { pg8::Gemm g{ACT, W2T, MP, D, FF}; pg8::StaticOrder S; S.init(MP, D, G, bx); pg8::EpiRes E{x_prompt, x_sample, H, HB, SSH, 0.5f};
        pg8::gemm_phase<pg8::EpiRes, pg8::StaticOrder, true, true>(lds + RING_OFF, g, S, E);
        for (int tl = vcu; tl < 256; tl += G) { thin_tile<11>(ACT, FF, W2T, FF, tl, (LAS float*)(lds + RING_OFF), tid); thin_res((const LAS float*)(lds + RING_OFF), tl, x_sample - (size_t)MP * D, H, HB, SSH, 0.5f, tid); __syncthreads(); } }
    SEAM(2);
    if (IN(3)) { pg8::Gemm g{HB, WINT, M, INC, D}; pg8::StaticOrder S; S.init(M, INC, G, bx); pg8::EpiInProj E{SSH, QB, KB, VB, UG, GA, GB, VG, VGS, out, QSCALE};
        pg8::gemm_phase<pg8::EpiInProj, pg8::StaticOrder, true, true>(lds + RING_OFF, g, S, E); }
    SEAM(3);
    if (IN(4)) {
#ifndef P4_SUB
#define P4_SUB 15
#endif
        if ((P4_SUB & 1) && G == 256) { const attn_body::AttnTensors AT{(const attn_body::bf16*)QB, (const attn_body::bf16*)KB, (const attn_body::bf16*)VB, (attn_body::bf16*)OV}; const attn_body::StaticOrder S((int)G, (int)blockIdx.x); attn_body::attn_phase<attn_body::StaticOrder>((char*)lds_raw + RING_OFF, AT, S); }
        __syncthreads();
        if (P4_SUB & 2) for (int d = vcu; d < 128 * DEC_NS; d += G) decode_unit(d / (4 * DEC_NS), (d / DEC_NS) & 3, d % DEC_NS, QB, cache_k, cache_v, page_table, DP, DML, lds + RING_OFF, tid);
        SpArgs sa; sa.VG = VG; sa.VGS = VGS; sa.ln_g = (const float*)args.in[15]; sa.ln_b = (const float*)args.in[16]; sa.w_s = (const float*)args.in[17]; sa.b_s = (const float*)args.in[18]; sa.UG = UG; sa.SG = SG; sa.out = out;
        if (P4_SUB & 4) for (int s = vcu; s < 512; s += G) spatial_unit(s >> 2, s & 3, sa, lds + RING_OFF, tid);
        if (P4_SUB & 8) for (int s = vcu; s < 32; s += G) spatial_sample_unit(s, sa, tid);
    }
    SEAM(4);
    if (IN(5)) { const float lam = LAM[0]; const float* subln = (const float*)args.in[14];
        combine_prompt(OV, subln, lam, AS, gw, NGW, lane);
        for (int k = vcu; k < 128; k += G) combine_sample(k >> 2, k & 3, QB, out, DP, DML, subln, lam, AS, lds + RING_OFF, tid); }
    SEAM(5);
    if (IN(6)) {
        { pg8::Gemm g{AS, WPAT, MP, D, 512}; pg8::StaticOrder S; S.init(MP, D, G, bx); pg8::EpiGate1 E{GA, T1};
          pg8::gemm_phase<pg8::EpiGate1, pg8::StaticOrder, true, true>(lds + RING_OFF, g, S, E); }
        asm volatile("s_waitcnt vmcnt(0)" ::: "memory");
        { pg8::Gemm g{SG, WPBT, MP, D, 512}; pg8::StaticOrder S; S.init(MP, D, G, bx); pg8::EpiGate2 E{GB, T1, MB};
          pg8::gemm_phase<pg8::EpiGate2, pg8::StaticOrder, true, true>(lds + RING_OFF, g, S, E); }
        for (int tl = vcu; tl < 256; tl += G) { LAS float* red = (LAS float*)(lds + RING_OFF); const int row = tid >> 5, c2 = (tid & 31) * 2; const size_t o = (size_t)(MP + 16 * (tl >> 4) + row) * 1024 + 64 * (tl & 15) + c2;
            thin_tile<2>(AS, 512, WPAT, 512, tl, red, tid);
            const unsigned ga = *(const unsigned*)(GA + o), gb = *(const unsigned*)(GB + o); const float t0 = bf_lo(ga) * red[row * 64 + c2], t1 = bf_hi(ga) * red[row * 64 + c2 + 1];
            __syncthreads();
            thin_tile<2>(SG, 512, WPBT, 512, tl, red, tid);
            *(unsigned*)(MB + o) = pk2(t0 + bf_lo(gb) * red[row * 64 + c2], t1 + bf_hi(gb) * red[row * 64 + c2 + 1]);
            __syncthreads(); }
    }
    SEAM(6);
    if (IN(7)) { pg8::Gemm g{MB, WOT, MP, D, D}; pg8::StaticOrder S; S.init(MP, D, G, bx); pg8::EpiRes E{H, H + (size_t)MP * D, H, HB, SSH, 1.0f};
        pg8::gemm_phase<pg8::EpiRes, pg8::StaticOrder, true, true>(lds + RING_OFF, g, S, E);
        for (int tl = vcu; tl < 256; tl += G) { thin_tile<4>(MB, D, WOT, D, tl, (LAS float*)(lds + RING_OFF), tid); thin_res((const LAS float*)(lds + RING_OFF), tl, H, H, HB, SSH, 1.0f, tid); __syncthreads(); } }
    SEAM(7);
    if (IN(8)) { pg8::Gemm g{HB, W3T, M, 2 * FF, D}; pg8::StaticOrder S; S.init(M, 2 * FF, G, bx); pg8::EpiSwiglu E{ACT, SSH};
        pg8::gemm_phase<pg8::EpiSwiglu, pg8::StaticOrder, true, true>(lds + RING_OFF, g, S, E); }
    SEAM(8);
    if (IN(9)) { pg8::Gemm g{ACT, W4T, MP, D, FF}; pg8::StaticOrder S; S.init(MP, D, G, bx); pg8::EpiRes E{H, H + (size_t)MP * D, out + O_Y, nullptr, SSO, 0.5f};
        pg8::gemm_phase<pg8::EpiRes, pg8::StaticOrder, true, true>(lds + RING_OFF, g, S, E);
        for (int tl = vcu; tl < 256; tl += G) { thin_tile<11>(ACT, FF, W4T, FF, tl, (LAS float*)(lds + RING_OFF), tid); thin_res((const LAS float*)(lds + RING_OFF), tl, H, out + O_Y, nullptr, SSO, 0.5f, tid); __syncthreads(); } }
    SEAM(9);
    if (IN(10)) final_norm(out + O_Y, SSO, (const float*)args.in[25], gw, NGW, lane);
#undef IN
#undef SEAM
}
extern "C" void kernel_launch(void* const* d_in, const int* in_sizes, int n_in, void* d_out, int out_size, void* d_ws, size_t ws_size, hipStream_t stream) {
    static int grid = 0;
    if (grid == 0) {
        if (n_in != 26 || out_size != (int)O_END || ws_size < WS_OPT_END) { fprintf(stderr, "kernel_launch: unexpected shapes (n_in %d out %d ws %zu need %zu); nothing launched\n", n_in, out_size, ws_size, (size_t)WS_OPT_END); grid = -1; return; }
        if (hipFuncSetAttribute((const void*)mega_fwd, hipFuncAttributeMaxDynamicSharedMemorySize, LDS_BYTES) != hipSuccess) { fprintf(stderr, "kernel_launch: hipFuncSetAttribute failed; nothing launched\n"); grid = -1; return; }
        int dev = 0, cus = 0, per_cu = 0;
        if (hipGetDevice(&dev) != hipSuccess || hipDeviceGetAttribute(&cus, hipDeviceAttributeMultiprocessorCount, dev) != hipSuccess) { grid = -1; return; }
        if (hipOccupancyMaxActiveBlocksPerMultiprocessor(&per_cu, (const void*)mega_fwd, NWAVES * 64, LDS_BYTES) != hipSuccess || per_cu < 1) { fprintf(stderr, "kernel_launch: occupancy query says %d workgroups per CU; nothing launched\n", per_cu); (void)hipGetLastError(); grid = -1; return; }
        grid = cus < 256 ? cus : 256;
    }
    if (grid < 0) return;
    (void)hipMemsetAsync((unsigned char*)d_ws + WS_CTL, 0, CTL_ZERO_BYTES, stream);
    Args a{}; for (int i = 0; i < 26; ++i) a.in[i] = d_in[i]; a.out = (float*)d_out; a.ws = (unsigned char*)d_ws; a.ph_lo = 0; a.ph_hi = N_PHASES;
    hipLaunchKernelGGL(mega_fwd, dim3(grid), dim3(NWAVES * 64), LDS_BYTES, stream, a);
}
```
